# Optimizing an MI355X kernel written in HIP

```python
import math
import jax, jax.numpy as jnp
from jax import lax
import numpy as np

D_MODEL = 2048
BATCH = 4
SEQ = 4096
DEPTH = 2
DEC_BATCH = 32
DEC_SEQ = 64
PAST_LEN = 2048

CHUNK = 64
N_PAST_CHUNKS = 8
BAND_PAST = N_PAST_CHUNKS * CHUNK
N_A_LAYERS = DEPTH // 2
N_B_LAYERS = DEPTH - N_A_LAYERS
SSM_GROUP = 16
SSM_GROUPS = D_MODEL // SSM_GROUP
SSM_STATE = 64
N_HEADS = 16
HEAD_DIM = D_MODEL // N_HEADS
REL_CLIP = 256
D_FF = (D_MODEL * 11) // 4
PLE_DIM = 256
RMS_EPS = 1e-6
MASK_VALUE = -1e30

kernel_name = 'streaming_s5_chunkband_yoco'


def rms_norm(x, g):
    xf = x.astype(jnp.float32)
    y = xf * lax.rsqrt(jnp.mean(xf * xf, axis=-1, keepdims=True) + RMS_EPS) * g.astype(jnp.float32)
    return y.astype(x.dtype)


def swiglu(x, w_gate, w_up, w_down):
    return (jax.nn.silu(x @ w_gate) * (x @ w_up)) @ w_down


def per_layer_embedding(h, p_i, norm_g, w_gate, w_proj):
    gate = jax.nn.sigmoid(rms_norm(h, norm_g) @ w_gate)
    return (p_i.astype(h.dtype) @ w_proj) * gate


def _ssm_combine(left, right):
    a_l, b_l = left
    a_r, b_r = right
    return a_l * a_r, a_r * b_l + b_r


def s5_mixer(u, h0, lam_re, lam_im, log_dt, b_re, b_im, c_re, c_im, d_skip, w_glu_a, w_glu_b):
    bsz, seq, _ = u.shape
    f32 = jnp.float32
    lam = lax.complex(lam_re.astype(f32), lam_im.astype(f32))
    dt = jnp.exp(log_dt.astype(f32))[:, None]
    lam_bar = jnp.exp(lam * dt)
    b_bar = ((lam_bar - 1.0) / lam)[:, :, None] * lax.complex(b_re.astype(f32), b_im.astype(f32))
    c_mat = lax.complex(c_re.astype(f32), c_im.astype(f32))
    blk = CHUNK if seq % CHUNK == 0 else seq
    n_blk = seq // blk
    u_blocks = jnp.moveaxis(u.astype(f32).reshape(bsz, n_blk, blk, SSM_GROUPS, SSM_GROUP), 1, 0)

    def step(h, u_blk):
        bu = jnp.einsum('gpc,btgc->btgp', b_bar, u_blk)
        bu = bu.at[:, 0].add(lam_bar * h)
        a = jnp.broadcast_to(lam_bar, bu.shape)
        _, hs = lax.associative_scan(_ssm_combine, (a, bu), axis=1)
        y_blk = jnp.einsum('gcp,btgp->btgc', c_mat, hs).real
        return hs[:, -1], y_blk

    h_last, y_blocks = lax.scan(step, h0, u_blocks)
    y = jnp.moveaxis(y_blocks, 0, 1).reshape(bsz, seq, D_MODEL) + d_skip.astype(f32) * u.astype(f32)
    z = jax.nn.gelu(y).astype(u.dtype)
    out = (z @ w_glu_a) * jax.nn.sigmoid(z @ w_glu_b)
    return out, h_last


def shared_kv(h, kv_norm_g, w_k, w_v, k_norm_g):
    bsz, seq, _ = h.shape
    hn = rms_norm(h, kv_norm_g)
    k = rms_norm((hn @ w_k).reshape(bsz, seq, N_HEADS, HEAD_DIM), k_norm_g)
    v = (hn @ w_v).reshape(bsz, seq, N_HEADS, HEAD_DIM)
    return k, v


def rel_index(dist):
    return jnp.clip(dist, -REL_CLIP, REL_CLIP) + REL_CLIP


def attend(q, k, v, bias, valid):
    s = jnp.einsum('bqhd,bkhd->bhqk', q, k).astype(jnp.float32) + bias
    if valid is not None:
        s = jnp.where(valid, s, MASK_VALUE)
    prob = jax.nn.softmax(s, axis=-1).astype(v.dtype)
    return jnp.einsum('bhqk,bkhd->bqhd', prob, v)


def prompt_band_attention(q, k, v, bias_tab):
    bsz, seq, n_h, d_h = q.shape
    n_chunks = seq // CHUNK
    band = BAND_PAST + CHUNK
    pad = ((0, 0), (BAND_PAST, 0), (0, 0), (0, 0))
    k_pad = jnp.pad(k, pad)
    v_pad = jnp.pad(v, pad)
    t = jnp.arange(CHUNK)
    j = jnp.arange(band)
    bias = bias_tab.astype(jnp.float32)[:, rel_index(BAND_PAST + t[:, None] - j[None, :])]
    q_chunks = jnp.moveaxis(q.reshape(bsz, n_chunks, CHUNK, n_h, d_h), 1, 0)

    def one_chunk(args):
        q_blk, c = args
        start = c * CHUNK
        k_blk = lax.dynamic_slice_in_dim(k_pad, start, band, axis=1)
        v_blk = lax.dynamic_slice_in_dim(v_pad, start, band, axis=1)
        valid = (start - BAND_PAST + j) >= 0
        return attend(q_blk, k_blk, v_blk, bias, valid)

    o = lax.map(one_chunk, (q_chunks, jnp.arange(n_chunks)))
    return jnp.moveaxis(o, 0, 1).reshape(bsz, seq, n_h, d_h)


def sample_band_attention(q, k_new, v_new, k_cache, v_cache, bias_tab):
    n_cache = k_cache.shape[1]
    seq = q.shape[1]
    k_all = jnp.concatenate([k_cache.astype(k_new.dtype), k_new], axis=1)
    v_all = jnp.concatenate([v_cache.astype(v_new.dtype), v_new], axis=1)
    q_pos = n_cache + jnp.arange(seq)
    k_pos = jnp.arange(n_cache + seq)
    bias = bias_tab.astype(jnp.float32)[:, rel_index(q_pos[:, None] - k_pos[None, :])]
    return attend(q, k_all, v_all, bias, None)


def chunk_band_mixer(hn, k_sh, v_sh, k_cache, v_cache, w_q, q_norm_g, bias_tab, w_o):
    bsz, seq, _ = hn.shape
    q = rms_norm((hn @ w_q).reshape(bsz, seq, N_HEADS, HEAD_DIM), q_norm_g) * (HEAD_DIM ** -0.5)
    if k_cache is None:
        o = prompt_band_attention(q, k_sh, v_sh, bias_tab)
    else:
        o = sample_band_attention(q, k_sh, v_sh, k_cache, v_cache, bias_tab)
    return o.reshape(bsz, seq, N_HEADS * HEAD_DIM) @ w_o


def run_trunk(x, p, ssm_h0, k_cache, v_cache, weights):
    (ffn1_norm_g, ffn1_w_gate, ffn1_w_up, ffn1_w_down,
     ffn2_norm_g, ffn2_w_gate, ffn2_w_up, ffn2_w_down,
     mix_norm_g, ssm_lam_re, ssm_lam_im, ssm_log_dt, ssm_b_re, ssm_b_im,
     ssm_c_re, ssm_c_im, ssm_d, ssm_w_glu_a, ssm_w_glu_b,
     kv_norm_g, w_k, w_v, k_norm_g, w_q, q_norm_g, rel_bias, w_o,
     ple_norm_g, ple_w_gate, ple_w_proj) = weights
    h = x
    ssm_final = []
    k_sh = None
    v_sh = None
    for i in range(DEPTH):
        if i == N_A_LAYERS:
            k_sh, v_sh = shared_kv(h, kv_norm_g, w_k, w_v, k_norm_g)
        h = h + 0.5 * swiglu(rms_norm(h, ffn1_norm_g[i]), ffn1_w_gate[i], ffn1_w_up[i], ffn1_w_down[i])
        hn = rms_norm(h, mix_norm_g[i])
        if i < N_A_LAYERS:
            mix, h_last = s5_mixer(hn, ssm_h0[i], ssm_lam_re[i], ssm_lam_im[i], ssm_log_dt[i],
                                   ssm_b_re[i], ssm_b_im[i], ssm_c_re[i], ssm_c_im[i], ssm_d[i],
                                   ssm_w_glu_a[i], ssm_w_glu_b[i])
            ssm_final.append(h_last)
        else:
            jb = i - N_A_LAYERS
            mix = chunk_band_mixer(hn, k_sh, v_sh, k_cache, v_cache, w_q[jb], q_norm_g[jb], rel_bias[jb], w_o[jb])
        h = h + mix
        h = h + 0.5 * swiglu(rms_norm(h, ffn2_norm_g[i]), ffn2_w_gate[i], ffn2_w_up[i], ffn2_w_down[i])
        h = h + per_layer_embedding(h, p[i], ple_norm_g[i], ple_w_gate[i], ple_w_proj[i])
    if k_cache is None:
        rows = min(BAND_PAST, x.shape[1])
        k_rows = k_sh[:, x.shape[1] - rows:]
        v_rows = v_sh[:, x.shape[1] - rows:]
    else:
        k_rows = k_sh
        v_rows = v_sh
    return h, jnp.stack(ssm_final, axis=0), k_rows, v_rows


def setup_inputs(seed: int = 0) -> dict:
    key = jax.random.key(seed)
    ks = iter(jax.random.split(key, 48))

    def nrm(shape, scale=1.0):
        return jax.random.normal(next(ks), shape, jnp.float32) * scale

    def gain(shape):
        return 1.0 + nrm(shape, 0.02)

    cache_rows = min(BAND_PAST, PAST_LEN)
    hd = N_HEADS * HEAD_DIM
    n_idx = jnp.arange(SSM_STATE, dtype=jnp.float32)
    ssm_shape = (N_A_LAYERS, SSM_GROUPS, SSM_STATE)
    return {
        'x_prompt': nrm((BATCH, SEQ, D_MODEL)),
        'x_sample': nrm((DEC_BATCH, DEC_SEQ, D_MODEL)),
        'state_ssm_re': nrm((N_A_LAYERS, DEC_BATCH, SSM_GROUPS, SSM_STATE), 0.3),
        'state_ssm_im': nrm((N_A_LAYERS, DEC_BATCH, SSM_GROUPS, SSM_STATE), 0.3),
        'cache_k': nrm((DEC_BATCH, cache_rows, N_HEADS, HEAD_DIM)),
        'cache_v': nrm((DEC_BATCH, cache_rows, N_HEADS, HEAD_DIM)),
        'p_prompt': nrm((DEPTH, BATCH, SEQ, PLE_DIM)),
        'p_sample': nrm((DEPTH, DEC_BATCH, DEC_SEQ, PLE_DIM)),
        'ffn1_norm_g': gain((DEPTH, D_MODEL)),
        'ffn1_w_gate': nrm((DEPTH, D_MODEL, D_FF), D_MODEL ** -0.5),
        'ffn1_w_up': nrm((DEPTH, D_MODEL, D_FF), D_MODEL ** -0.5),
        'ffn1_w_down': nrm((DEPTH, D_FF, D_MODEL), D_FF ** -0.5),
        'ffn2_norm_g': gain((DEPTH, D_MODEL)),
        'ffn2_w_gate': nrm((DEPTH, D_MODEL, D_FF), D_MODEL ** -0.5),
        'ffn2_w_up': nrm((DEPTH, D_MODEL, D_FF), D_MODEL ** -0.5),
        'ffn2_w_down': nrm((DEPTH, D_FF, D_MODEL), D_FF ** -0.5),
        'mix_norm_g': gain((DEPTH, D_MODEL)),
        'ssm_lam_re': -0.5 + nrm(ssm_shape, 0.01),
        'ssm_lam_im': math.pi * n_idx + nrm(ssm_shape, 0.01),
        'ssm_log_dt': jax.random.uniform(next(ks), (N_A_LAYERS, SSM_GROUPS), jnp.float32,
                                         math.log(1e-3), math.log(1e-1)),
        'ssm_b_re': nrm((N_A_LAYERS, SSM_GROUPS, SSM_STATE, SSM_GROUP), (2 * SSM_GROUP) ** -0.5),
        'ssm_b_im': nrm((N_A_LAYERS, SSM_GROUPS, SSM_STATE, SSM_GROUP), (2 * SSM_GROUP) ** -0.5),
        'ssm_c_re': nrm((N_A_LAYERS, SSM_GROUPS, SSM_GROUP, SSM_STATE), SSM_STATE ** -0.5),
        'ssm_c_im': nrm((N_A_LAYERS, SSM_GROUPS, SSM_GROUP, SSM_STATE), SSM_STATE ** -0.5),
        'ssm_d': nrm((N_A_LAYERS, D_MODEL)),
        'ssm_w_glu_a': nrm((N_A_LAYERS, D_MODEL, D_MODEL), D_MODEL ** -0.5),
        'ssm_w_glu_b': nrm((N_A_LAYERS, D_MODEL, D_MODEL), D_MODEL ** -0.5),
        'kv_norm_g': gain((D_MODEL,)),
        'w_k': nrm((D_MODEL, hd), D_MODEL ** -0.5),
        'w_v': nrm((D_MODEL, hd), D_MODEL ** -0.5),
        'k_norm_g': gain((HEAD_DIM,)),
        'w_q': nrm((N_B_LAYERS, D_MODEL, hd), D_MODEL ** -0.5),
        'q_norm_g': gain((N_B_LAYERS, HEAD_DIM)),
        'rel_bias': nrm((N_B_LAYERS, N_HEADS, 2 * REL_CLIP + 1), 0.1),
        'w_o': nrm((N_B_LAYERS, hd, D_MODEL), hd ** -0.5),
        'ple_norm_g': gain((DEPTH, D_MODEL)),
        'ple_w_gate': nrm((DEPTH, D_MODEL, D_MODEL), D_MODEL ** -0.5),
        'ple_w_proj': nrm((DEPTH, PLE_DIM, D_MODEL), PLE_DIM ** -0.5),
    }


def reference(x_prompt, x_sample, state_ssm_re, state_ssm_im, cache_k, cache_v, p_prompt, p_sample,
              ffn1_norm_g, ffn1_w_gate, ffn1_w_up, ffn1_w_down,
              ffn2_norm_g, ffn2_w_gate, ffn2_w_up, ffn2_w_down,
              mix_norm_g, ssm_lam_re, ssm_lam_im, ssm_log_dt, ssm_b_re, ssm_b_im,
              ssm_c_re, ssm_c_im, ssm_d, ssm_w_glu_a, ssm_w_glu_b,
              kv_norm_g, w_k, w_v, k_norm_g, w_q, q_norm_g, rel_bias, w_o,
              ple_norm_g, ple_w_gate, ple_w_proj):
    weights = (ffn1_norm_g, ffn1_w_gate, ffn1_w_up, ffn1_w_down,
               ffn2_norm_g, ffn2_w_gate, ffn2_w_up, ffn2_w_down,
               mix_norm_g, ssm_lam_re, ssm_lam_im, ssm_log_dt, ssm_b_re, ssm_b_im,
               ssm_c_re, ssm_c_im, ssm_d, ssm_w_glu_a, ssm_w_glu_b,
               kv_norm_g, w_k, w_v, k_norm_g, w_q, q_norm_g, rel_bias, w_o,
               ple_norm_g, ple_w_gate, ple_w_proj)
    h0_prompt = jnp.zeros((N_A_LAYERS, x_prompt.shape[0], SSM_GROUPS, SSM_STATE), jnp.complex64)
    h0_sample = lax.complex(state_ssm_re.astype(jnp.float32), state_ssm_im.astype(jnp.float32))
    y_prompt, ssm_p, k_p, v_p = run_trunk(x_prompt, p_prompt, h0_prompt, None, None, weights)
    y_sample, ssm_s, k_s, v_s = run_trunk(x_sample, p_sample, h0_sample, cache_k, cache_v, weights)
    return (y_prompt, y_sample, jnp.real(ssm_p), jnp.imag(ssm_p), k_p, v_p,
            jnp.real(ssm_s), jnp.imag(ssm_s), k_s, v_s)
```

```cpp
#include <hip/hip_runtime.h>
#include <cstdio>
#include <cstdint>
namespace pg8 {
#define PG8_LAS __attribute__((address_space(3)))
typedef unsigned short bf16_t;
typedef short bf16x8 __attribute__((ext_vector_type(8)));
typedef float f32x4 __attribute__((ext_vector_type(4)));
typedef unsigned u32x4 __attribute__((ext_vector_type(4)));
constexpr int BM = 256, BK = 64, HALF = 128, HTB = HALF * BK * 2  , STAGE_BYTES = 8 * HTB, NXCD = 8, WGM = 8;

__host__ __device__ __forceinline__ int lds_byte(int r, int c) { const int st = (r >> 4) * 2 + (c >> 5), rr = r & 15, cc = c & 31, ob = rr * 64 + cc * 2; return st * 1024 + (ob ^ (((ob >> 9) & 1) << 5)); }
__host__ __device__ __forceinline__ void stage_rc(int b, int& R, int& C) { const int st = b / 1024, sb = b % 1024, swz = sb ^ (((sb >> 9) & 1) << 5); R = (st >> 1) * 16 + swz / 64; C = (st & 1) * 32 + (swz % 64) / 2; }
__host__ __device__ __forceinline__ int perm32(int rho) { const int n = rho >> 4, i = rho & 15; return 8 * (i >> 2) + 4 * n + (i & 3); }

struct Unit { int pm, pn; };
struct Gemm { const bf16_t* A; const bf16_t* Bt; int M, N, K, lda, ldb; int ksA = 0, ksB = 0; long tsA = 0, tsB = 0; int sbA = 0; };

struct RangeOrder {
    int first, count, nN;
    __host__ __device__ bool next(int i, Unit& u) const { if (i >= count) return false; const int id = first + i; u.pm = id / nN; u.pn = id - u.pm * nN; return true; }
    __device__ __forceinline__ void a_ready(const Unit&) const {}
    __device__ __forceinline__ void done(const Unit&) const {}
};
struct StaticOrder {
    int nM, nN, nwg, G, c, wgm;
    __host__ __device__ void init(int M, int N, int G_, int c_, int bm = BM, int wgm_ = WGM) { nM = M / bm; nN = N / BM; nwg = nM * nN; G = G_; c = c_; wgm = wgm_; }
    __host__ __device__ bool next(int i, Unit& u) const {
        const long L = (long)i * G + c; if (L >= nwg) return false;
        int wgid = (int)L; { const int q = nwg / NXCD, r = nwg % NXCD, xcd = wgid % NXCD, off = wgid / NXCD; wgid = (xcd < r ? xcd * (q + 1) : r * (q + 1) + (xcd - r) * q) + off; }
        const int nig = wgm * nN, gid = wgid / nig, fm = gid * wgm, gsz = (nM - fm) < wgm ? (nM - fm) : wgm;
        u.pm = fm + ((wgid % nig) % gsz); u.pn = (wgid % nig) / gsz; return true;
    }
    __device__ __forceinline__ void a_ready(const Unit&) const {}
    __device__ __forceinline__ void done(const Unit&) const {}
};

typedef float f32x2 __attribute__((ext_vector_type(2)));
typedef unsigned u32x2 __attribute__((ext_vector_type(2)));
typedef __bf16 bf16x2_t __attribute__((ext_vector_type(2)));
__device__ __forceinline__ unsigned cvt_pk_bf16(float lo, float hi) { f32x2 v = {lo, hi}; bf16x2_t b = __builtin_convertvector(v, bf16x2_t); return __builtin_bit_cast(unsigned, b); }
__device__ __forceinline__ float sigm(float x) { return __builtin_amdgcn_rcpf(1.0f + __builtin_amdgcn_exp2f(-1.4426950408889634f * x)); }
__device__ __forceinline__ f32x4 sigm4(f32x4 x) { f32x4 r; r[0] = sigm(x[0]); r[1] = sigm(x[1]); r[2] = sigm(x[2]); r[3] = sigm(x[3]); return r; }
constexpr int MTOK = 18432, MPROMPT = 16384, DM = 2048, FFH = 5632;
#ifndef ACT_PR
#define ACT_PR 192
#endif
constexpr float RMS_EPS = 1e-6f;

template <int MT> struct EpiUp {
    static constexpr bool PERM = true, AFTER_DRAIN = false;
    bf16_t* O; const float* ssq; int ldo;
    __device__ __forceinline__ void operator()(const f32x4 (&acc)[2][2][MT][2], const Unit& u, int wr, int wc, int fr, int fq) const {
        const int row0 = u.pm * (64 * MT) + wr * (16 * MT) + fr, col0 = u.pn * HALF + wc * 32 + 8 * fq;
        float sv[2][MT];
#pragma unroll
        for (int ai = 0; ai < 2; ++ai)
#pragma unroll
            for (int m = 0; m < MT; ++m) sv[ai][m] = ssq[row0 + ai * (32 * MT) + m * 16];
#pragma unroll
        for (int ai = 0; ai < 2; ++ai)
#pragma unroll
            for (int m = 0; m < MT; ++m) {
                const int row = row0 + ai * (32 * MT) + m * 16;
                const float rs = rsqrtf(sv[ai][m] * (1.0f / 2048.0f) + RMS_EPS);
                const f32x4 g0 = acc[ai][0][m][0] * rs, g1 = acc[ai][0][m][1] * rs, u0 = acc[ai][1][m][0] * rs, u1 = acc[ai][1][m][1] * rs;
                const f32x4 o0 = g0 * sigm4(g0) * u0, o1 = g1 * sigm4(g1) * u1;
                u32x4 w; w.x = cvt_pk_bf16(o0[0], o0[1]); w.y = cvt_pk_bf16(o0[2], o0[3]); w.z = cvt_pk_bf16(o1[0], o1[1]); w.w = cvt_pk_bf16(o1[2], o1[3]);
                if (ldo) *(u32x4*)(O + (size_t)row * ldo + col0) = w;
                else { const int pnl = row / ACT_PR, rr = row - pnl * ACT_PR;
                    *(u32x4*)((char*)O + (size_t)pnl * ((FFH / 32) * ACT_PR * 64) + (size_t)(col0 >> 5) * (ACT_PR * 64) + rr * 64 + (col0 & 31) * 2) = w; }
            }
    }
};
template <int MT> struct EpiProj {
    static constexpr bool PERM = true, AFTER_DRAIN = false;
    bf16_t* O; int ldo;
    __device__ __forceinline__ void operator()(const f32x4 (&acc)[2][2][MT][2], const Unit& u, int wr, int wc, int fr, int fq) const {
        const int row0 = u.pm * (64 * MT) + wr * (16 * MT) + fr, col0 = u.pn * BM + wc * 32 + 8 * fq;
#pragma unroll
        for (int ai = 0; ai < 2; ++ai)
#pragma unroll
            for (int m = 0; m < MT; ++m) {
                bf16_t* rowp = O + (size_t)(row0 + ai * (32 * MT) + m * 16) * ldo + col0;
#pragma unroll
                for (int bj = 0; bj < 2; ++bj) { const f32x4 v0 = acc[ai][bj][m][0], v1 = acc[ai][bj][m][1];
                    u32x4 w; w.x = cvt_pk_bf16(v0[0], v0[1]); w.y = cvt_pk_bf16(v0[2], v0[3]); w.z = cvt_pk_bf16(v1[0], v1[1]); w.w = cvt_pk_bf16(v1[2], v1[3]);
                    *(u32x4*)(rowp + bj * HALF) = w; }
            }
    }
};
__device__ __forceinline__ f32x4 bf4_to_f32(u32x2 w) { f32x4 v; v[0] = __uint_as_float(w.x << 16); v[1] = __uint_as_float(w.x & 0xffff0000u); v[2] = __uint_as_float(w.y << 16); v[3] = __uint_as_float(w.y & 0xffff0000u); return v; }
template <int MODE, int MT, bool BASEF32> struct EpiRes {
    static constexpr bool PERM = true, AFTER_DRAIN = false;
    const float* baseP; const float* baseS; const bf16_t* baseHb; float* outH; bf16_t* outHb; float* ssq_out; const float* ssq_in; const bf16_t* proj; float scale; int ldhb;
    __device__ __forceinline__ void operator()(const f32x4 (&acc)[2][2][MT][2], const Unit& u, int wr, int wc, int fr, int fq) const {
        asm volatile("" : "+v"(fr), "+v"(fq));
        constexpr int NB = (MODE == 1) ? 1 : 2;
        constexpr int MB = (MT == 4) ? 2 : ((MODE == 2) ? 1 : 3);
        const int row0 = u.pm * (64 * MT) + wr * (16 * MT) + fr;
        const int col0 = (MODE == 1 ? u.pn * HALF : u.pn * BM) + wc * 32 + 8 * fq;
#pragma unroll
        for (int ai = 0; ai < 2; ++ai)
#pragma unroll
            for (int mb = 0; mb < MT; mb += MB) {
                f32x4 hb[MB][NB][2]; u32x4 hw[MB][NB]; u32x4 pj[MB][NB]; float sv[MB];
#pragma unroll
                for (int mm = 0; mm < MB; ++mm) {
                    const int row = row0 + ai * (32 * MT) + (mb + mm) * 16;
                    if (MODE == 2) sv[mm] = ssq_in[row];
#pragma unroll
                    for (int bj = 0; bj < NB; ++bj) { const int cc = col0 + bj * HALF;
                        if (BASEF32) { const float* xp = (row < MPROMPT ? baseP : baseS - (size_t)MPROMPT * DM) + (size_t)row * DM + cc; hb[mm][bj][0] = *(const f32x4*)xp; hb[mm][bj][1] = *(const f32x4*)(xp + 4); }
                        else hw[mm][bj] = *(const u32x4*)(baseHb + (size_t)row * ldhb + cc);
                        if (MODE == 2) pj[mm][bj] = *(const u32x4*)(proj + (size_t)row * DM + cc); }
                }
#pragma unroll
                for (int mm = 0; mm < MB; ++mm) {
                    const int m = mb + mm, row = row0 + ai * (32 * MT) + m * 16;
                    float rs = 1.f; if (MODE == 2) rs = rsqrtf(sv[mm] * (1.0f / 2048.0f) + RMS_EPS);
                    float s = 0.f;
#pragma unroll
                    for (int bj = 0; bj < NB; ++bj) {
                        const int cc = col0 + bj * HALF;
                        f32x4 hn[2];
#pragma unroll
                        for (int n = 0; n < 2; ++n) {
                            f32x4 val;
                            if (MODE == 0) val = acc[ai][bj][m][n] * scale;
                            else if (MODE == 1) val = acc[ai][0][m][n] * sigm4(acc[ai][1][m][n]);
                            else { u32x2 pw; pw.x = n ? pj[mm][bj].z : pj[mm][bj].x; pw.y = n ? pj[mm][bj].w : pj[mm][bj].y; val = bf4_to_f32(pw) * sigm4(acc[ai][bj][m][n] * rs); }
                            f32x4 bs;
                            if (BASEF32) bs = hb[mm][bj][n];
                            else { u32x2 bw; bw.x = n ? hw[mm][bj].z : hw[mm][bj].x; bw.y = n ? hw[mm][bj].w : hw[mm][bj].y; bs = bf4_to_f32(bw); }
                            hn[n] = bs + val;
                            s += (hn[n][0] * hn[n][0] + hn[n][1] * hn[n][1]) + (hn[n][2] * hn[n][2] + hn[n][3] * hn[n][3]);
                        }
                        if (outH) { float* op = outH + (size_t)row * DM + cc; *(f32x4*)op = hn[0]; *(f32x4*)(op + 4) = hn[1]; }
                        if (outHb) { u32x4 w; w.x = cvt_pk_bf16(hn[0][0], hn[0][1]); w.y = cvt_pk_bf16(hn[0][2], hn[0][3]); w.z = cvt_pk_bf16(hn[1][0], hn[1][1]); w.w = cvt_pk_bf16(hn[1][2], hn[1][3]);
                            *(u32x4*)(outHb + (size_t)row * ldhb + cc) = w; }
                    }
                    if (ssq_out) { s += __shfl_xor(s, 16); s += __shfl_xor(s, 32); if (fq == 0) unsafeAtomicAdd(ssq_out + row, s); }
                }
                asm volatile("" ::: "memory");
            }
    }
};
template <int KIND, int MT> struct EpiHead {
    static constexpr bool PERM = true, AFTER_DRAIN = false;
    const float* ssq_in; const float* gain; float qscale; PG8_LAS float* xch;
    bf16_t* kP; bf16_t* kS; bf16_t* vP; bf16_t* vS; float* o_pk; float* o_pv; float* o_sk; float* o_sv; int ldq;
    __device__ __forceinline__ void operator()(const f32x4 (&acc)[2][2][MT][2], const Unit& u, int wr, int wc, int fr, int fq) const {
        asm volatile("" : "+v"(fr), "+v"(fq));
        const bool isV = (KIND == 0) && (u.pn >= 8);
        const int rl0 = wr * (16 * MT) + fr;
#pragma unroll
        for (int ai = 0; ai < 2; ++ai)
#pragma unroll
            for (int m = 0; m < MT; ++m) {
                const int rl = rl0 + ai * (32 * MT) + m * 16;

#pragma unroll
                for (int bj = 0; bj < 2; ++bj) {
                    const f32x4 a = acc[ai][bj][m][0], b = acc[ai][bj][m][1];
                    float s = (a[0] * a[0] + a[1] * a[1]) + (a[2] * a[2] + a[3] * a[3]) + (b[0] * b[0] + b[1] * b[1]) + (b[2] * b[2] + b[3] * b[3]);
                    s += __shfl_xor(s, 16); s += __shfl_xor(s, 32);
                    if (fq == 0) xch[(bj * 256 + rl) * 4 + wc] = s;
                }
            }
        asm volatile("s_waitcnt lgkmcnt(0)" ::: "memory"); __builtin_amdgcn_s_barrier(); asm volatile("" ::: "memory");
        const int cw = wc * 32 + 8 * fq;
        const int ct = (u.pn & 7) * BM + cw;
        float sv[2][MT];
#pragma unroll
        for (int ai = 0; ai < 2; ++ai)
#pragma unroll
            for (int m = 0; m < MT; ++m) sv[ai][m] = ssq_in[u.pm * (64 * MT) + rl0 + ai * (32 * MT) + m * 16];
#pragma unroll
        for (int ai = 0; ai < 2; ++ai)
#pragma unroll
            for (int m = 0; m < MT; ++m) {
                const int rl = rl0 + ai * (32 * MT) + m * 16, row = u.pm * (64 * MT) + rl;
                const float rs = rsqrtf(sv[ai][m] * (1.0f / 2048.0f) + RMS_EPS);
                bf16_t* dst; float* fdst = nullptr;
                if (KIND == 1) dst = kP + (size_t)row * ldq;
                else if (row < MPROMPT) { dst = (isV ? vP : kP) + (size_t)row * DM; const int t = row & 4095; if (t >= 3584) fdst = (isV ? o_pv : o_pk) + (size_t)((row >> 12) * 512 + t - 3584) * DM; }
                else { const int r2 = row - MPROMPT; dst = (isV ? vS : kS) + (size_t)((r2 >> 6) * 576 + 512 + (r2 & 63)) * DM; fdst = (isV ? o_sv : o_sk) + (size_t)r2 * DM; }
#pragma unroll
                for (int bj = 0; bj < 2; ++bj) {
                    const f32x4 ps = *(const PG8_LAS f32x4*)(xch + (bj * 256 + rl) * 4);
                    float sc = rs;
                    if (!isV) { const float ss = ((ps[0] + ps[1]) + (ps[2] + ps[3])) * rs * rs; sc = rs * rsqrtf(ss * (1.0f / 128.0f) + RMS_EPS) * qscale; }
                    f32x4 v0 = acc[ai][bj][m][0] * sc, v1 = acc[ai][bj][m][1] * sc;
                    if (!isV) { v0 = v0 * *(const f32x4*)(gain + cw); v1 = v1 * *(const f32x4*)(gain + cw + 4); }
                    u32x4 w; w.x = cvt_pk_bf16(v0[0], v0[1]); w.y = cvt_pk_bf16(v0[2], v0[3]); w.z = cvt_pk_bf16(v1[0], v1[1]); w.w = cvt_pk_bf16(v1[2], v1[3]);
                    *(u32x4*)(dst + ct + bj * HALF) = w;
                    if (KIND == 0 && fdst) { *(f32x4*)(fdst + ct + bj * HALF) = v0; *(f32x4*)(fdst + ct + bj * HALF + 4) = v1; }
                }
            }
    }
};
template <class Epi, class Sched, bool ALIGN_EPI = false, bool SP2 = false, int MT = 4>
__device__ __forceinline__ void gemm_phase(PG8_LAS unsigned char* lds, const Gemm g, const Sched& S, const Epi& E) {
    int tid = threadIdx.x; asm volatile("" : "+v"(tid));
    const int wid = __builtin_amdgcn_readfirstlane(tid >> 6), lane = tid & 63, wr = wid >> 2, wc = wid & 3, fr = lane & 15, fq = lane >> 4;
    const int K = g.K, nt = K / BK, lda = g.lda, ldb = g.ldb; constexpr int HA = 32 * MT;
    unsigned voffA[2], voffB[2];
#pragma unroll
    for (int i = 0; i < 2; ++i) { int R, C; stage_rc(tid * 16 + i * 8192, R, C); const int Rb = Epi::PERM ? ((R & ~31) + perm32(R & 31)) : R;
        const int Ra = (R >= HA) ? R - 32 : R; voffA[i] = g.sbA ? (unsigned)((C >> 5) * g.sbA + Ra * 32 + (C & 31)) * 2u : (unsigned)(Ra * lda + C) * 2u; voffB[i] = (unsigned)(Rb * ldb + C) * 2u; }
    const size_t kstepA = g.ksA ? (size_t)g.ksA : (size_t)(BK * 2), kstepB = g.ksB ? (size_t)g.ksB : (size_t)(BK * 2);
    const size_t hstepA = g.sbA ? (size_t)HA * 64 : (size_t)HA * lda * 2, hstepB = (size_t)HALF * ldb * 2;
    const size_t tstepA = g.tsA ? (size_t)g.tsA : 2 * hstepA, tstepB = g.tsB ? (size_t)g.tsB : 2 * hstepB;
    const unsigned ldsw = (unsigned)wid * 1024u;
    const int aoff = lds_byte(wr * (16 * MT) + fr, fq * 8), boff = lds_byte(wc * 32 + fr, fq * 8);
#define PG8_SA(b, h) (((b) * 2 + (h)) * HTB)
#define PG8_SB(b, h) ((4 + (b) * 2 + (h)) * HTB)
#define PG8_STAGE(bufoff, gbase, voff) do { _Pragma("unroll") for (int _i = 0; _i < 2; ++_i) \
        __builtin_amdgcn_global_load_lds((const unsigned*)((const char*)(gbase) + (voff)[_i]), (PG8_LAS unsigned*)(lds + (bufoff) + ldsw + _i * 8192), 16, 0, 0); } while (0)
#define PG8_LDA(dst, b, h) do { _Pragma("unroll") for (int m = 0; m < MT; ++m) _Pragma("unroll") for (int k = 0; k < 2; ++k) dst[m][k] = *(const PG8_LAS bf16x8*)(lds + PG8_SA(b, h) + aoff + m * 2048 + k * 1024); } while (0)
#define PG8_LDB(dst, b, h) do { _Pragma("unroll") for (int n = 0; n < 2; ++n) _Pragma("unroll") for (int k = 0; k < 2; ++k) dst[n][k] = *(const PG8_LAS bf16x8*)(lds + PG8_SB(b, h) + boff + n * 2048 + k * 1024); } while (0)
#define PG8_MMA(ai, bj, At, Bt) do { __builtin_amdgcn_s_setprio(1); _Pragma("unroll") for (int m = 0; m < MT; ++m) _Pragma("unroll") for (int n = 0; n < 2; ++n) _Pragma("unroll") for (int k = 0; k < 2; ++k) \
        acc[ai][bj][m][n] = __builtin_amdgcn_mfma_f32_16x16x32_bf16(Bt[n][k], At[m][k], acc[ai][bj][m][n], 0, 0, 0); __builtin_amdgcn_s_setprio(0); } while (0)
#define PG8_WAIT_V(n) asm volatile("s_waitcnt vmcnt(" #n ")" ::: "memory")
#define PG8_WAIT_L(n) asm volatile("s_waitcnt lgkmcnt(" #n ")" ::: "memory")
#define PG8_BAR __builtin_amdgcn_s_barrier()
#define PG8_SCHED __builtin_amdgcn_sched_barrier(0)
    Unit cur, nxt; int ui = 0;
    if (!S.next(0, cur)) return;
    f32x4 acc[2][2][MT][2];
#pragma unroll
    for (int a = 0; a < 2; ++a)
#pragma unroll
        for (int b = 0; b < 2; ++b)
#pragma unroll
            for (int m = 0; m < MT; ++m)
#pragma unroll
                for (int n = 0; n < 2; ++n) acc[a][b][m][n] = (f32x4){0.f, 0.f, 0.f, 0.f};
    bf16x8 At[MT][2], B0[2][2], B1[2][2];
    const char* cA = (const char*)g.A + (size_t)cur.pm * tstepA; const char* cB = (const char*)g.Bt + (size_t)cur.pn * tstepB;
    S.a_ready(cur);
    if constexpr (SP2) {
        PG8_STAGE(PG8_SB(0, 0), cB, voffB); PG8_STAGE(PG8_SB(0, 1), cB + hstepB, voffB); PG8_STAGE(PG8_SA(0, 0), cA, voffA); PG8_STAGE(PG8_SA(0, 1), cA + hstepA, voffA);
        if (wr == 1) PG8_BAR;
        PG8_WAIT_V(2); PG8_BAR;
        PG8_STAGE(PG8_SB(1, 0), cB + kstepB, voffB); PG8_STAGE(PG8_SA(1, 0), cA + kstepA, voffA); PG8_STAGE(PG8_SB(1, 1), cB + hstepB + kstepB, voffB);
        PG8_WAIT_V(6); PG8_BAR;
    } else {
        PG8_STAGE(PG8_SB(0, 0), cB, voffB); PG8_STAGE(PG8_SA(0, 0), cA, voffA); PG8_STAGE(PG8_SB(0, 1), cB + hstepB, voffB); PG8_STAGE(PG8_SA(0, 1), cA + hstepA, voffA);
        if (wr == 1) PG8_BAR;
        PG8_WAIT_V(4); PG8_BAR;
        PG8_STAGE(PG8_SB(1, 0), cB + kstepB, voffB); PG8_STAGE(PG8_SA(1, 0), cA + kstepA, voffA); PG8_STAGE(PG8_SB(1, 1), cB + hstepB + kstepB, voffB);
        PG8_WAIT_V(6); PG8_BAR;
    }
    for (;;) {
        const bool has_next = S.next(ui + 1, nxt);
        const char* nA = has_next ? (const char*)g.A + (size_t)nxt.pm * tstepA : cA; const char* nB = has_next ? (const char*)g.Bt + (size_t)nxt.pn * tstepB : cB;
        for (int t = 0; t < nt; t += 2) {
            const bool last = (t == nt - 2);
            const char* a1 = cA + (size_t)(t + 1) * kstepA;
            const char* a2 = last ? nA : cA + (size_t)(t + 2) * kstepA; const char* b2 = last ? nB : cB + (size_t)(t + 2) * kstepB;
            const char* a3 = a2 + kstepA; const char* b3 = b2 + kstepB;
            if (last && has_next) S.a_ready(nxt);
            if constexpr (SP2) {
            PG8_LDB(B0, 0, 0); PG8_LDB(B1, 0, 1); PG8_SCHED; PG8_LDA(At, 0, 0); PG8_STAGE(PG8_SA(1, 1), a1 + hstepA, voffA);
            PG8_WAIT_V(8); PG8_WAIT_L(0); PG8_BAR; PG8_MMA(0, 0, At, B0); PG8_MMA(0, 1, At, B1); PG8_BAR; PG8_SCHED;
            PG8_LDA(At, 0, 1); PG8_STAGE(PG8_SB(0, 0), b2, voffB); PG8_STAGE(PG8_SB(0, 1), b2 + hstepB, voffB); PG8_STAGE(PG8_SA(0, 0), a2, voffA);
            PG8_WAIT_V(8); PG8_WAIT_L(0); PG8_BAR; PG8_MMA(1, 0, At, B0); PG8_MMA(1, 1, At, B1); PG8_BAR; PG8_SCHED;
            PG8_LDB(B0, 1, 0); PG8_LDB(B1, 1, 1); PG8_SCHED; PG8_LDA(At, 1, 0); PG8_STAGE(PG8_SA(0, 1), a2 + hstepA, voffA);
            PG8_WAIT_V(8); PG8_WAIT_L(0); PG8_BAR; PG8_MMA(0, 0, At, B0); PG8_MMA(0, 1, At, B1); PG8_BAR; PG8_SCHED;
            PG8_LDA(At, 1, 1); PG8_STAGE(PG8_SB(1, 0), b3, voffB); PG8_STAGE(PG8_SB(1, 1), b3 + hstepB, voffB); PG8_STAGE(PG8_SA(1, 0), a3, voffA);
            PG8_WAIT_V(8); PG8_WAIT_L(0); PG8_BAR; PG8_MMA(1, 0, At, B0); PG8_MMA(1, 1, At, B1); PG8_BAR; PG8_SCHED;
            } else {
            PG8_LDB(B0, 0, 0); PG8_SCHED; PG8_LDA(At, 0, 0); PG8_STAGE(PG8_SA(1, 1), a1 + hstepA, voffA);
            PG8_WAIT_L(8); PG8_BAR; PG8_WAIT_L(0); PG8_MMA(0, 0, At, B0); PG8_BAR; PG8_SCHED;
            PG8_LDB(B1, 0, 1); PG8_STAGE(PG8_SB(0, 0), b2, voffB);
            PG8_BAR; PG8_WAIT_L(0); PG8_MMA(0, 1, At, B1); PG8_BAR;
            PG8_LDA(At, 0, 1); PG8_STAGE(PG8_SA(0, 0), a2, voffA);
            PG8_BAR; PG8_WAIT_L(0); PG8_MMA(1, 0, At, B0); PG8_BAR; PG8_SCHED;
            PG8_STAGE(PG8_SB(0, 1), b2 + hstepB, voffB);
            PG8_WAIT_V(6); PG8_BAR; PG8_MMA(1, 1, At, B1); PG8_BAR;
            PG8_LDB(B0, 1, 0); PG8_SCHED; PG8_LDA(At, 1, 0); PG8_STAGE(PG8_SA(0, 1), a2 + hstepA, voffA);
            PG8_WAIT_L(8); PG8_BAR; PG8_WAIT_L(0); PG8_MMA(0, 0, At, B0); PG8_BAR; PG8_SCHED;
            PG8_LDB(B1, 1, 1); PG8_STAGE(PG8_SB(1, 0), b3, voffB);
            PG8_BAR; PG8_WAIT_L(0); PG8_MMA(0, 1, At, B1); PG8_BAR;
            PG8_LDA(At, 1, 1); PG8_STAGE(PG8_SA(1, 0), a3, voffA);
            PG8_BAR; PG8_WAIT_L(0); PG8_MMA(1, 0, At, B0); PG8_BAR; PG8_SCHED;
            PG8_STAGE(PG8_SB(1, 1), b3 + hstepB, voffB);
            PG8_WAIT_V(6); PG8_BAR; PG8_MMA(1, 1, At, B1); PG8_BAR;
            }
        }
        if constexpr (ALIGN_EPI) { if (wr == 0) PG8_BAR; }
        if constexpr (!Epi::AFTER_DRAIN) { E(acc, cur, wr, wc, fr, fq); S.done(cur); }
        if (!has_next) break;
#pragma unroll
        for (int a = 0; a < 2; ++a)
#pragma unroll
            for (int b = 0; b < 2; ++b)
#pragma unroll
                for (int m = 0; m < MT; ++m)
#pragma unroll
                    for (int n = 0; n < 2; ++n) acc[a][b][m][n] = (f32x4){0.f, 0.f, 0.f, 0.f};
        cur = nxt; cA = nA; cB = nB; ++ui;
        if constexpr (ALIGN_EPI) { if (wr == 1) PG8_BAR; }
    }
    PG8_WAIT_V(0);
    if constexpr (!ALIGN_EPI) { if (wr == 0) PG8_BAR; }
    PG8_BAR;
    if constexpr (Epi::AFTER_DRAIN) { E.fused(acc, cur, wr, wc, fr, fq, lds, wid, lane); S.done(cur); }
#undef PG8_SA
#undef PG8_SB
#undef PG8_STAGE
#undef PG8_LDA
#undef PG8_LDB
#undef PG8_MMA
#undef PG8_WAIT_V
#undef PG8_WAIT_L
#undef PG8_BAR
#undef PG8_SCHED
}
}

constexpr int NWAVES = 8;
constexpr int M = 18432, MP = 16384, MS = 2048, D = 2048, FF = 5632, NH = 16, HD = 128, PLE = 256;
constexpr int SEQ = 4096, DSEQ = 64, DB = 32, NG = 128, NP = 64, CROWS = 512, SROWS = 576;
#ifndef MK_ONE_LAUNCH
#define MK_ONE_LAUNCH 1
#endif
constexpr int N_PHASES = 24;
#ifndef WD_BLOCKED
#define WD_BLOCKED 0
#endif
#ifndef ACT_BLOCKED
#define ACT_BLOCKED 1
#endif
#ifndef MT_DOWN
#define MT_DOWN 3
#endif
#ifndef WGM_UP
#define WGM_UP 8
#endif
#ifndef SP2_UP
#define SP2_UP true
#endif
#ifndef WGM_N2048
#define WGM_N2048 8
#endif
#ifndef ALIGN_RES
#define ALIGN_RES false
#endif
#ifndef MT_UP
#define MT_UP 4
#endif
#ifndef MT_N2048
#define MT_N2048 3
#endif
#ifndef MT_N4096
#define MT_N4096 4
#endif
constexpr size_t MiB = 1u << 20;
#ifndef KPAD
#define KPAD 64
#endif
constexpr int LDH = D + KPAD, LDACT = FF + KPAD, LDPB = PLE + KPAD;
constexpr size_t WS_CTL = 0, CTL_ZERO_BYTES = 1 * MiB;
constexpr size_t WS_SSQ = 256 * 1024;
constexpr size_t WS_WL = 2 * MiB, WL_STRIDE = 149 * MiB;
constexpr size_t WL_1GU = 0, WL_1D = 46 * MiB, WL_2GU = 69 * MiB, WL_2D = 115 * MiB, WL_PG = 138 * MiB, WL_PP = 147 * MiB;
constexpr size_t WS_WGLU = 300 * MiB, WS_WKV = 317 * MiB, WS_WQ = 334 * MiB, WS_WO = 343 * MiB;
constexpr size_t WS_HB = 352 * MiB;
constexpr size_t WS_ACT = 427 * MiB;
constexpr size_t WS_PROJ = 628 * MiB;
constexpr size_t WS_KP = 700 * MiB, WS_VP = 764 * MiB;
constexpr size_t WS_KS = 828 * MiB, WS_VS = 900 * MiB;
constexpr size_t WS_PB = 972 * MiB;
constexpr size_t WS_S5L = 1011 * MiB;
constexpr size_t WS_S5B = 1012 * MiB;
constexpr size_t WS_TAB = 1013 * MiB;
constexpr size_t WS_HB2 = 1014 * MiB;
constexpr size_t WS_END = 1089 * MiB;
static_assert((size_t)M * LDH * 2 <= 75 * MiB && (size_t)M * LDACT * 2 <= 201 * MiB && (size_t)2 * FF * LDH * 2 <= 46 * MiB && (size_t)D * LDACT * 2 <= 23 * MiB && (size_t)D * LDH * 2 <= 9 * MiB && (size_t)D * LDPB * 2 <= 2 * MiB && (size_t)2 * M * LDPB * 2 <= 23 * MiB && (size_t)2 * D * LDH * 2 <= 17 * MiB, "d_ws map");
constexpr int CW_BAR = 4096;
constexpr int RING_BYTES = 131072, XCH_OFF = 131072, XCH_BYTES = 8192, MISC_OFF = XCH_OFF + XCH_BYTES, LDS_BYTES = 147456;

#define GAS __attribute__((address_space(1)))
#define LAS __attribute__((address_space(3)))
typedef unsigned short bf16;
typedef unsigned v4u __attribute__((ext_vector_type(4)));
typedef unsigned v2u __attribute__((ext_vector_type(2)));
typedef float f32x4 __attribute__((ext_vector_type(4)));
typedef float f32x16 __attribute__((ext_vector_type(16)));
typedef short bf16x8 __attribute__((ext_vector_type(8)));
typedef short s16x4 __attribute__((ext_vector_type(4)));
typedef GAS unsigned gu32;
#define RLX_AGENT __ATOMIC_RELAXED, __HIP_MEMORY_SCOPE_AGENT
#define LDS_WAIT() asm volatile("s_waitcnt lgkmcnt(0)" ::: "memory")
#define VM_WAIT() asm volatile("s_waitcnt vmcnt(0)" ::: "memory")
__device__ __forceinline__ unsigned pk2(float lo, float hi) { return pg8::cvt_pk_bf16(lo, hi); }
__device__ __forceinline__ float bf2f(unsigned short b) { return __uint_as_float(((unsigned)b) << 16); }
#define XB_TMO      128
#define XB_XCNT(j)  (256  + 64 * (j))
#define XB_XSUB(j)  (1280 + 64 * (j))
#define XB_XGEN(j)  (2304 + 64 * (j))
#define XB_TOP      3328
#define XB_TOPGEN   3392
#define XCD_BAR_WORDS 3456
#define XB_SPIN_CAP (1u << 18)

__device__ __forceinline__ unsigned xb_ld(unsigned* p)              { return __hip_atomic_load(p, __ATOMIC_RELAXED, __HIP_MEMORY_SCOPE_AGENT); }
__device__ __forceinline__ unsigned xb_add(unsigned* p, unsigned v) { return __hip_atomic_fetch_add(p, v, __ATOMIC_RELAXED, __HIP_MEMORY_SCOPE_AGENT); }
__device__ __forceinline__ unsigned xb_xcc_id() { return (unsigned)__builtin_amdgcn_s_getreg((3 << 11) | 20) & 0xFu; }
#define XB_SPIN(cond, bar) do { unsigned _sp = 0; while (cond) { __builtin_amdgcn_s_sleep(1); \
    if ((++_sp & 255u) == 0u) { if (xb_ld(&(bar)[XB_TMO])) break; if (_sp > XB_SPIN_CAP) { atomicAdd(&(bar)[XB_TMO], 1u); break; } } } } while (0)

struct XcdBarrier {
    unsigned* bar; unsigned x;
    volatile LAS unsigned* st;
};

__device__ __forceinline__ XcdBarrier xcd_barrier_post(unsigned* bar, volatile LAS unsigned* st) {
    XcdBarrier b; b.bar = bar; b.x = xb_xcc_id(); b.st = st;
    if (threadIdx.x == 0) (void)xb_add(&bar[XB_XCNT(b.x)], 1u);
    return b;
}
__device__ __forceinline__ void xcd_barrier_complete(unsigned* bar, unsigned x, unsigned& nloc, unsigned& nx) {
    const unsigned G = gridDim.x * gridDim.y * gridDim.z;
    unsigned sum, cnt, mine, sp = 0u;
    for (;;) {
        sum = 0u; cnt = 0u; mine = 0u;
#pragma unroll
        for (unsigned j = 0; j < 16; ++j) { const unsigned c = xb_ld(&bar[XB_XCNT(j)]); sum += c; cnt += (c > 0u) ? 1u : 0u; mine = (j == x) ? c : mine; }
        if (sum == G) break;
        __builtin_amdgcn_s_sleep(1);
        if ((++sp & 255u) == 0u) { if (xb_ld(&bar[XB_TMO])) break; if (sp > XB_SPIN_CAP) { atomicAdd(&bar[XB_TMO], 1u); break; } }
    }
    nloc = mine > 0u ? mine : 1u; nx = cnt > 0u ? cnt : 1u;
}

__device__ __forceinline__ void xcd_barrier(const XcdBarrier& b) {
    asm volatile("s_waitcnt vmcnt(0)" ::: "memory");
    __syncthreads();
    if (threadIdx.x == 0) {
        unsigned* bar = b.bar;
        __builtin_amdgcn_s_waitcnt(0);
        unsigned nloc = b.st[0], nx = b.st[1];
        if (nloc == 0u) { xcd_barrier_complete(bar, b.x, nloc, nx); b.st[0] = nloc; b.st[1] = nx; }
        const unsigned old = xb_add(&bar[XB_XSUB(b.x)], 1u);
        const unsigned gen = old / nloc;
        if (old + 1u == (gen + 1u) * nloc) {
            __builtin_amdgcn_fence(__ATOMIC_RELEASE, "agent");
            asm volatile("s_waitcnt vmcnt(0)" ::: "memory");
            const unsigned og = xb_add(&bar[XB_TOP], 1u);
            const unsigned tg = og / nx;
            if (og + 1u == (tg + 1u) * nx) xb_add(&bar[XB_TOPGEN], 1u);
            else XB_SPIN(xb_ld(&bar[XB_TOPGEN]) == tg, bar);
            __builtin_amdgcn_fence(__ATOMIC_ACQUIRE, "agent");
            xb_add(&bar[XB_XGEN(b.x)], 1u);
            asm volatile("s_waitcnt vmcnt(0)" ::: "memory");
        } else {
            XB_SPIN(xb_ld(&bar[XB_XGEN(b.x)]) == gen, bar);
            __builtin_amdgcn_fence(__ATOMIC_ACQUIRE, "agent");
            asm volatile("s_waitcnt vmcnt(0)" ::: "memory");
        }
    }
    __syncthreads();
}

struct Args { const float* in[38]; float* out; unsigned char* ws; int ph_lo, ph_hi; };
enum { I_XP = 0, I_XS, I_SRE, I_SIM, I_CK, I_CV, I_PP, I_PS, I_F1G, I_F1WG, I_F1WU, I_F1WD, I_F2G, I_F2WG, I_F2WU, I_F2WD, I_MIXG, I_LRE, I_LIM, I_LDT, I_BRE, I_BIM, I_CRE, I_CIM, I_SD, I_GLA, I_GLB,
       I_KVG, I_WK, I_WV, I_KNG, I_WQ, I_QNG, I_RB, I_WO, I_PLG, I_PLWG, I_PLWP };
constexpr size_t O_YP = 0, O_YS = 33554432, O_PSRE = 37748736, O_PSIM = O_PSRE + 32768, O_PK = O_PSIM + 32768, O_PV = O_PK + 4194304, O_SSRE = O_PV + 4194304, O_SSIM = O_SSRE + 262144,
                 O_SK = O_SSIM + 262144, O_SV = O_SK + 4194304, O_END = O_SV + 4194304;
static_assert(O_END == 55115776, "output size");

__device__ __forceinline__ float wave_sum(float v) {
#pragma unroll
    for (int o = 1; o < 64; o <<= 1) v += __shfl_xor(v, o);
    return v;
}
struct TrRegs { float v[32]; };
__device__ __forceinline__ void tr_load(TrRegs& r, const float* W, int N, const float* gain, int item, int lane) {
    const int nblk = N / 32, kb = item / nblk, nb = item % nblk, k0 = 64 * kb, n0 = 32 * nb;
    const float* p = W + (size_t)(k0 + (lane >> 3)) * N + n0 + 4 * (lane & 7);
#pragma unroll
    for (int j = 0; j < 8; ++j) { const f32x4 t = *(const GAS f32x4*)(p + (size_t)(8 * j) * N); r.v[4 * j] = t[0]; r.v[4 * j + 1] = t[1]; r.v[4 * j + 2] = t[2]; r.v[4 * j + 3] = t[3]; }
    if (gain) {
#pragma unroll
        for (int j = 0; j < 8; ++j) { const float gk = gain[k0 + (lane >> 3) + 8 * j]; r.v[4 * j] *= gk; r.v[4 * j + 1] *= gk; r.v[4 * j + 2] *= gk; r.v[4 * j + 3] *= gk; }
    }
}
__device__ __forceinline__ void tr_store(const TrRegs& r, int K, int N, bf16* WT, int ldk, int blk, int row_off, LAS float* scr, int item, int lane) {
    const int nblk = N / 32, kb = item / nblk, nb = item % nblk, k0 = 64 * kb, n0 = 32 * nb;
#pragma unroll
    for (int i = 0; i < 32; ++i) scr[((lane >> 3) + 8 * (i >> 2)) * 33 + 4 * (lane & 7) + (i & 3)] = r.v[i];
    LDS_WAIT(); asm volatile("" ::: "memory");
    const int c = lane & 7;
#pragma unroll
    for (int j = 0; j < 4; ++j) { const int n = (lane >> 3) + 8 * j; const LAS float* s = scr + (8 * c) * 33 + n;
        v4u o; o.x = pk2(s[0 * 33], s[1 * 33]); o.y = pk2(s[2 * 33], s[3 * 33]); o.z = pk2(s[4 * 33], s[5 * 33]); o.w = pk2(s[6 * 33], s[7 * 33]);
        const int nn = n0 + n, drow = (nn >> 7) * blk + (nn & 127) + row_off;
        if (ldk) *(GAS v4u*)(WT + (size_t)drow * ldk + k0 + 8 * c) = o;
        else *(GAS v4u*)((char*)WT + (size_t)(drow >> 8) * ((size_t)(K / 64) * 32768) + (size_t)(k0 >> 6) * 32768 + (drow & 255) * 128 + 16 * c) = o; }
    LDS_WAIT(); asm volatile("" ::: "memory");
}
__device__ __forceinline__ void tr_matrix(const float* W, int K, int N, const float* gain, bf16* WT, int blk, int row_off, LAS float* scr, int gw, int NGW, int lane, int& base, bool blocked = false) {
    const int ldk = blocked ? 0 : K + KPAD;
    const int items = (K / 64) * (N / 32);
    int st = (gw - (base % NGW)); if (st < 0) st += NGW;
    base += items;
    if (st >= items) return;
    TrRegs cur, nxt;
    tr_load(cur, W, N, gain, st, lane);
    for (int it = st; it < items; it += NGW) {
        const bool more = it + NGW < items;
        if (more) tr_load(nxt, W, N, gain, it + NGW, lane);
        tr_store(cur, K, N, WT, ldk, blk, row_off, scr, it, lane);
        if (more) {
#pragma unroll
            for (int i = 0; i < 32; ++i) cur.v[i] = nxt.v[i];
        }
    }
}
__device__ __forceinline__ float row2048_to_bf16(const float* src, bf16* dst, int lane) {
    const GAS f32x4* xr = (const GAS f32x4*)src + lane; GAS v2u* o8 = (GAS v2u*)dst + lane; float s = 0.f;
    f32x4 v[8];
#pragma unroll
    for (int j = 0; j < 8; ++j) v[j] = xr[64 * j];
#pragma unroll
    for (int j = 0; j < 8; ++j) { s += (v[j][0] * v[j][0] + v[j][1] * v[j][1]) + (v[j][2] * v[j][2] + v[j][3] * v[j][3]); v2u w; w.x = pk2(v[j][0], v[j][1]); w.y = pk2(v[j][2], v[j][3]); o8[64 * j] = w; }
    return s;
}


__device__ __forceinline__ pg8::RangeOrder proj_tail(int G, int bx, int part) {
    constexpr int NN = D / 256, P = (M / (64 * MT_N2048)) * NN, NWG_UP = (M / (64 * MT_UP)) * (2 * FF / 256);
    pg8::RangeOrder S; S.nN = NN; S.first = 0; S.count = 0;
    const int rem = NWG_UP % G, ns = G - rem, a = 3 * ns, R = P - a, n2 = R - ns;
    if (rem == 0 || R < 0 || n2 < 0 || n2 > ns) { if (part == 0) { const int per = (P + G - 1) / G; S.first = bx * per; S.count = P - S.first < per ? P - S.first : per; if (S.count < 0) S.count = 0; } return S; }
    const int c = bx - rem;
    if (c < 0) return S;
    if (part == 0) { S.first = 3 * c; S.count = 3; }
    else { S.count = c < n2 ? 2 : 1; S.first = a + (c < n2 ? 2 * c : 2 * n2 + (c - n2)); }
    return S;
}

__device__ __forceinline__ float gelu_tanh(float x) {
    const float a = 0.7978845608028654f * (x + 0.044715f * x * x * x);
    return x * __builtin_amdgcn_rcpf(1.0f + __builtin_amdgcn_exp2f(-2.885390081777927f * a));
}
__device__ __forceinline__ void s5_stage_u(const float* h, const float* ssq, const float* gm, int row0, int g, LAS float* ut, int lane) {
    const int row = row0 + lane;
    const float rs = rsqrtf(ssq[row] * (1.0f / 2048.0f) + 1e-6f);
    const f32x4* hp = (const f32x4*)(h + (size_t)row * D + 16 * g); const f32x4* gp = (const f32x4*)(gm + 16 * g);
#pragma unroll
    for (int k = 0; k < 4; ++k) { const f32x4 v = hp[k] * rs * gp[k]; *(LAS f32x4*)(ut + lane * 16 + 4 * k) = v; }
    LDS_WAIT(); asm volatile("" ::: "memory");
}

__device__ __forceinline__ void s5_prefix(const f32x4* lamtab, float2* E, int gw, int NGW, int lane) {
    float2* HIN = E + (size_t)4 * 64 * NG * NP;
    for (int it = gw; it < 4 * NG; it += NGW) {
        const int g = it & 127, b = it >> 7;
        const f32x4 lam = lamtab[g * 64 + lane];
        const size_t base = ((size_t)b * 64 * 128 + g) * 64 + lane;
        float2 e[63];
#pragma unroll
        for (int c = 0; c < 63; ++c) e[c] = E[base + (size_t)c * 128 * 64];
        float hr = 0.f, hi = 0.f;
        HIN[base] = make_float2(0.f, 0.f);
#pragma unroll
        for (int c = 0; c < 63; ++c) { const float t = lam[2] * hr - lam[3] * hi + e[c].x; hi = lam[2] * hi + lam[3] * hr + e[c].y; hr = t; HIN[base + (size_t)(c + 1) * 128 * 64] = make_float2(hr, hi); }
    }
}
constexpr int S5_HS = 16 * 272;
constexpr int S5_WAVE_LDS = 2 * S5_HS + 2048 + 1024;
template <bool WITH_Y>
__device__ __forceinline__ void s5_mfma(const bf16* h, const float* ssq, const float* gm, const f32x4* lamtab, const float* bbar, const float* cre_g, const float* cim_g, const float* dsk, float2* E,
                                        const float* sre, const float* sim, bf16* zb, float* o_pre, float* o_pim, float* o_sre, float* o_sim, LAS char* wl, int gw, int NGW, int lane, bool emode) {
    const int col = lane & 31, hh = lane >> 5;
    const int NIT = (WITH_Y && !emode) ? (2 * 64 * NG + 16 * NG) : (2 * 64 * NG);
    LAS float* ut = (LAS float*)(wl + 2 * S5_HS); LAS unsigned short* zt = (LAS unsigned short*)(wl + 2 * S5_HS + 2048);
    for (int it = gw; it < NIT; it += NGW) {
        const bool samp = it >= 2 * 64 * NG;
        int g, c, b0;
        if (!samp) { g = it & 127; c = (it >> 7) & 63; b0 = 2 * (it >> 13); } else { const int i2 = it - 2 * 64 * NG; g = i2 & 127; c = 0; b0 = 2 * (i2 >> 7); }
        const int rowbase0 = samp ? MP + b0 * DSEQ : b0 * SEQ + c * 64;
        const int seqstride = samp ? DSEQ : SEQ;
        f32x4 lamA = lamtab[g * 64 + col], lamB = lamtab[g * 64 + col + 32];
        bf16x8 bhi[4], blo[4];
#pragma unroll
        for (int cb = 0; cb < 4; ++cb) { const float* bp = bbar + (size_t)(g * 64 + col + 32 * (cb & 1)) * 32 + 16 * (cb >> 1) + 8 * hh;
            const f32x4 x0 = *(const f32x4*)bp, x1 = *(const f32x4*)(bp + 4); float xv[8] = {x0[0], x0[1], x0[2], x0[3], x1[0], x1[1], x1[2], x1[3]}; unsigned hw[4], lw[4];
#pragma unroll
            for (int j = 0; j < 4; ++j) { const unsigned hp = pk2(xv[2 * j], xv[2 * j + 1]); hw[j] = hp; lw[j] = pk2(xv[2 * j] - __uint_as_float(hp << 16), xv[2 * j + 1] - __uint_as_float(hp & 0xffff0000u)); }
            v4u a; a.x = hw[0]; a.y = hw[1]; a.z = hw[2]; a.w = hw[3]; bhi[cb] = __builtin_bit_cast(bf16x8, a); a.x = lw[0]; a.y = lw[1]; a.z = lw[2]; a.w = lw[3]; blo[cb] = __builtin_bit_cast(bf16x8, a); }
        const f32x4 gm0 = *(const f32x4*)(gm + 16 * g + 8 * hh), gm1 = *(const f32x4*)(gm + 16 * g + 8 * hh + 4);
        bf16x8 cf[4]; float dch = 0.f;
        if (WITH_Y) {
            const int cc = lane & 15, kg = lane >> 4;
#pragma unroll
            for (int s = 0; s < 4; ++s) { const int p0 = 8 * s + 2 * kg;
                const float* cr = cre_g + (size_t)(g * 16 + cc) * 64 + p0; const float* ci = cim_g + (size_t)(g * 16 + cc) * 64 + p0;
                v4u a; a.x = pk2(cr[0], -ci[0]); a.y = pk2(cr[32], -ci[32]); a.z = pk2(cr[1], -ci[1]); a.w = pk2(cr[33], -ci[33]); cf[s] = __builtin_bit_cast(bf16x8, a); }
            dch = dsk[16 * g + cc];
        }
        float hAr = 0.f, hAi = 0.f, hBr = 0.f, hBi = 0.f;
        if (WITH_Y && !emode) {
            if (!samp) { { const float2* hin = E + (size_t)4 * 64 * NG * NP + (((size_t)(b0 + hh) * 64 + c) * 128 + g) * 64;
                    const float2 ea = hin[col], ec = hin[col + 32]; hAr = ea.x; hAi = ea.y; hBr = ec.x; hBi = ec.y; } }
            else { const size_t sb = (size_t)((b0 + hh) * NG + g) * 64; hAr = sre[sb + col]; hAi = sim[sb + col]; hBr = sre[sb + col + 32]; hBi = sim[sb + col + 32]; }
        }
        const int aseq = (col >> 2) & 1, atok = (col & 3) + 4 * (col >> 3);
        {
        const int rb0 = rowbase0; const bool doy = WITH_Y && !emode;
        for (int blk = 0; blk < 4; ++blk) {
            const int arow = rb0 + aseq * seqstride + 16 * blk + atok;
            const float rs = rsqrtf(ssq[arow] * (1.0f / 2048.0f) + 1e-6f);
            const v4u hraw = *(const GAS v4u*)(h + (size_t)arow * LDH + 16 * g + 8 * hh);
            f32x4 h0, h1; h0[0] = __uint_as_float(hraw.x << 16); h0[1] = __uint_as_float(hraw.x & 0xffff0000u); h0[2] = __uint_as_float(hraw.y << 16); h0[3] = __uint_as_float(hraw.y & 0xffff0000u);
            h1[0] = __uint_as_float(hraw.z << 16); h1[1] = __uint_as_float(hraw.z & 0xffff0000u); h1[2] = __uint_as_float(hraw.w << 16); h1[3] = __uint_as_float(hraw.w & 0xffff0000u);
            const f32x4 u0 = h0 * rs * gm0, u1 = h1 * rs * gm1;
            bf16x8 ahi, alo;
            { float xv[8] = {u0[0], u0[1], u0[2], u0[3], u1[0], u1[1], u1[2], u1[3]}; unsigned hw[4], lw[4];
#pragma unroll
              for (int j = 0; j < 4; ++j) { const unsigned hp = pk2(xv[2 * j], xv[2 * j + 1]); hw[j] = hp; lw[j] = pk2(xv[2 * j] - __uint_as_float(hp << 16), xv[2 * j + 1] - __uint_as_float(hp & 0xffff0000u)); }
              v4u a; a.x = hw[0]; a.y = hw[1]; a.z = hw[2]; a.w = hw[3]; ahi = __builtin_bit_cast(bf16x8, a); a.x = lw[0]; a.y = lw[1]; a.z = lw[2]; a.w = lw[3]; alo = __builtin_bit_cast(bf16x8, a); }
            if (WITH_Y && doy) { LAS f32x4* up = (LAS f32x4*)(ut + (aseq * 16 + atok) * 16 + 8 * hh); up[0] = u0; up[1] = u1; }
            f32x16 bu[4];
#pragma unroll
            for (int cb = 0; cb < 4; ++cb) {
#pragma unroll
                for (int i = 0; i < 16; ++i) bu[cb][i] = 0.f;
                bu[cb] = __builtin_amdgcn_mfma_f32_32x32x16_bf16(alo, bhi[cb], bu[cb], 0, 0, 0);
                bu[cb] = __builtin_amdgcn_mfma_f32_32x32x16_bf16(ahi, blo[cb], bu[cb], 0, 0, 0);
                bu[cb] = __builtin_amdgcn_mfma_f32_32x32x16_bf16(ahi, bhi[cb], bu[cb], 0, 0, 0);
            }
#pragma unroll
            for (int i = 0; i < 16; ++i) {
                float t = lamA[0] * hAr - lamA[1] * hAi + bu[0][i]; hAi = lamA[0] * hAi + lamA[1] * hAr + bu[2][i]; hAr = t;
                t = lamB[0] * hBr - lamB[1] * hBi + bu[1][i]; hBi = lamB[0] * hBi + lamB[1] * hBr + bu[3][i]; hBr = t;
                if (WITH_Y && doy) { v2u w; w.x = pk2(hAr, hAi); w.y = pk2(hBr, hBi); *(LAS s16x4*)(wl + hh * S5_HS + i * 272 + col * 8) = __builtin_bit_cast(s16x4, w); }
            }
            if (WITH_Y && doy) {
                asm volatile("" ::: "memory");
                const int cc = lane & 15, kg = lane >> 4;
#pragma unroll
                for (int sq = 0; sq < 2; ++sq) {
                    f32x4 y = {0.f, 0.f, 0.f, 0.f};
#pragma unroll
                    for (int s = 0; s < 4; ++s) { const bf16x8 af = *(const LAS bf16x8*)(wl + sq * S5_HS + cc * 272 + 64 * s + 16 * kg);
                        y = __builtin_amdgcn_mfma_f32_16x16x32_bf16(af, cf[s], y, 0, 0, 0); }
#pragma unroll
                    for (int r = 0; r < 4; ++r) { const float uu = ut[(sq * 16 + 4 * kg + r) * 16 + cc]; const float z = gelu_tanh(y[r] + dch * uu);
                        zt[(sq * 16 + 4 * kg + r) * 16 + cc] = (unsigned short)(pk2(z, 0.f) & 0xffffu); }
                }
                asm volatile("" ::: "memory");
                if (lane < 32) { const int sq = lane >> 4, tok = lane & 15;
                    const bf16x8 z0 = *(const LAS bf16x8*)(zt + lane * 16), z1 = *(const LAS bf16x8*)(zt + lane * 16 + 8);
                    GAS bf16x8* zp = (GAS bf16x8*)(zb + (size_t)(rb0 + sq * seqstride + 16 * blk + tok) * LDH + 16 * g); zp[0] = z0; zp[1] = z1; }
            }
            asm volatile("" ::: "memory");
        }
        }
        if (!WITH_Y || emode) { const size_t eb = (((size_t)(b0 + hh) * 64 + c) * 128 + g) * 64; E[eb + col] = make_float2(hAr, hAi); E[eb + col + 32] = make_float2(hBr, hBi); }
        else if (samp || c == 63) { float* ore = samp ? o_sre : o_pre; float* oim = samp ? o_sim : o_pim; const size_t sb = (size_t)((b0 + hh) * NG + g) * 64;
            ore[sb + col] = hAr; oim[sb + col] = hAi; ore[sb + col + 32] = hBr; oim[sb + col + 32] = hBi; }
    }
}

namespace att {
typedef short v4i16_t __attribute__((ext_vector_type(4)));
constexpr int KBUF = 16384;
constexpr int K_OFF = 0, V_OFF = 2 * KBUF, TAB_OFF = 4 * KBUF, Q_OFF = TAB_OFF + 2560, ATT_LDS = Q_OFF + 8 * 8192;
__device__ __forceinline__ unsigned off_b(unsigned row, unsigned ch) { return 256u * row + 16u * (ch ^ (((row & 3) << 2) | ((row >> 2) & 3))); }
__device__ __forceinline__ s16x4 vtr(const LAS char* p) { return __builtin_bit_cast(s16x4, __builtin_amdgcn_ds_read_tr16_b64_v4i16((LAS v4i16_t*)p)); }
__device__ __forceinline__ int crow(int r, int hi) { return (r & 3) + 8 * (r >> 2) + 4 * hi; }
__device__ __forceinline__ void attn_unit(LAS char* lds, const bf16* Q, size_t qrow0, const bf16* Kseq, const bf16* Vseq, int hh, int cq0, int nqc, const float* tabg, bf16* O, int tid) {
    const int lane = tid & 63, w = __builtin_amdgcn_readfirstlane(tid >> 6), r = lane & 31, h = lane >> 5;
    const int wq = w >> 1; const bool active = wq < nqc; const int cq = cq0 + (active ? wq : 0);
    LAS float* tab = (LAS float*)(lds + TAB_OFF);
    for (int i = tid; i < 640; i += 512) tab[i] = tabg[i];
    const size_t qrow = qrow0 + (size_t)(active ? wq : 0) * 64 + (w & 1) * 32 + r;
    LAS char* qpark = lds + Q_OFF + w * 8192 + lane * 16;
#pragma unroll
    for (int s = 0; s < 8; ++s) *(LAS bf16x8*)(qpark + 1024 * s) = *(const bf16x8*)(Q + qrow * LDH + hh * HD + 16 * s + 8 * h);
    const int kc_lo = (cq0 - 8 > 0) ? cq0 - 8 : 0, kc_hi = cq0 + nqc - 1;
    const int srow0 = tid >> 4, sch = tid & 15;
    v4u kreg[2], vreg[2];
#define ATT_GLOAD(kc) do { _Pragma("unroll") for (int i = 0; i < 2; ++i) { const size_t go = ((size_t)(kc) * 64 + srow0 + 32 * i) * D + hh * HD + sch * 8; kreg[i] = *(const GAS v4u*)(Kseq + go); vreg[i] = *(const GAS v4u*)(Vseq + go); } } while (0)
#define ATT_LSTORE(buf) do { _Pragma("unroll") for (int i = 0; i < 2; ++i) { const unsigned o = off_b(srow0 + 32 * i, sch); *(LAS v4u*)(lds + K_OFF + (buf) * KBUF + o) = kreg[i]; *(LAS v4u*)(lds + V_OFF + (buf) * KBUF + o) = vreg[i]; } } while (0)
    ATT_GLOAD(kc_lo); ATT_LSTORE(0);
    __syncthreads();
    f32x16 o[4];
#pragma unroll
    for (int c = 0; c < 4; ++c)
#pragma unroll
        for (int i = 0; i < 16; ++i) o[c][i] = 0.f;
    float mrun = -1e30f, lsum = 0.f;
    const int tq = 32 * (w & 1) + r;
    const int q4 = (lane & 15) >> 2, p4 = lane & 3, blk16 = (lane >> 4) & 1;
    for (int kc = kc_lo; kc <= kc_hi; ++kc) {
        const int cur = (kc - kc_lo) & 1;
        if (kc < kc_hi) ATT_GLOAD(kc + 1);
        if (active && kc >= cq - 8 && kc <= cq) {
            const int jrel = kc - (cq - 8);
            const LAS char* Kb = lds + K_OFF + cur * KBUF; const LAS char* Vb = lds + V_OFF + cur * KBUF;
            f32x16 p0, p1;
#pragma unroll
            for (int i = 0; i < 16; ++i) { p0[i] = 0.f; p1[i] = 0.f; }
#pragma unroll
            for (int s = 0; s < 8; ++s) {
                const bf16x8 k0 = *(const LAS bf16x8*)(Kb + off_b(r, 2 * s + h)), k1 = *(const LAS bf16x8*)(Kb + off_b(32 + r, 2 * s + h));
                const bf16x8 qs = *(const LAS bf16x8*)(qpark + 1024 * s);
                p0 = __builtin_amdgcn_mfma_f32_32x32x16_bf16(k0, qs, p0, 0, 0, 0); p1 = __builtin_amdgcn_mfma_f32_32x32x16_bf16(k1, qs, p1, 0, 0, 0);
                if ((s & 1) == 1) __builtin_amdgcn_sched_barrier(0);
            }
            const LAS float* tb = tab + (64 * jrel + 63 - tq + 4 * h);
            float mx = -1e30f;
#pragma unroll
            for (int i = 0; i < 16; ++i) { const int kr = (i & 3) + 8 * (i >> 2); p0[i] += tb[kr]; p1[i] += tb[kr + 32]; mx = fmaxf(mx, fmaxf(p0[i], p1[i])); }
            __builtin_amdgcn_sched_barrier(0);
            mx = fmaxf(mx, __shfl_xor(mx, 32));
            const float mnew = fmaxf(mrun, mx), alpha = __builtin_amdgcn_exp2f(mrun - mnew); mrun = mnew;
            float ps = 0.f;
#pragma unroll
            for (int i = 0; i < 16; ++i) { p0[i] = __builtin_amdgcn_exp2f(p0[i] - mnew); p1[i] = __builtin_amdgcn_exp2f(p1[i] - mnew); ps += p0[i] + p1[i]; }
            lsum = lsum * alpha + ps;
#pragma unroll
            for (int c = 0; c < 4; ++c)
#pragma unroll
                for (int i = 0; i < 16; ++i) o[c][i] *= alpha;
#pragma unroll
            for (int blk = 0; blk < 2; ++blk)
#pragma unroll
                for (int s2 = 0; s2 < 2; ++s2) {
                    const f32x16& pp = blk ? p1 : p0;
                    v4u pw; pw.x = pk2(pp[8 * s2], pp[8 * s2 + 1]); pw.y = pk2(pp[8 * s2 + 2], pp[8 * s2 + 3]); pw.z = pk2(pp[8 * s2 + 4], pp[8 * s2 + 5]); pw.w = pk2(pp[8 * s2 + 6], pp[8 * s2 + 7]);
                    const bf16x8 pf = __builtin_bit_cast(bf16x8, pw);
                    const int R0 = 32 * blk + 16 * s2 + 4 * h + q4;
#pragma unroll
                    for (int c = 0; c < 4; ++c) {
                        const unsigned ch = 4 * c + 2 * blk16 + (p4 >> 1);
                        const s16x4 lo = vtr(Vb + off_b(R0, ch) + 8 * (p4 & 1)), hi = vtr(Vb + off_b(R0 + 8, ch) + 8 * (p4 & 1));
                        const bf16x8 vf = __builtin_shufflevector(lo, hi, 0, 1, 2, 3, 4, 5, 6, 7);
                        o[c] = __builtin_amdgcn_mfma_f32_32x32x16_bf16(vf, pf, o[c], 0, 0, 0);
                    }
                    __builtin_amdgcn_sched_barrier(0);
                }
        }
        if (kc < kc_hi) ATT_LSTORE(cur ^ 1);
        __syncthreads();
    }
#undef ATT_GLOAD
#undef ATT_LSTORE
    if (active) {
        const float lt = lsum + __shfl_xor(lsum, 32), inv = 1.0f / lt;
        bf16* op = O + qrow * LDH + hh * HD + 4 * h;
#pragma unroll
        for (int c = 0; c < 4; ++c)
#pragma unroll
            for (int g4 = 0; g4 < 4; ++g4) { v2u wv; wv.x = pk2(o[c][4 * g4] * inv, o[c][4 * g4 + 1] * inv); wv.y = pk2(o[c][4 * g4 + 2] * inv, o[c][4 * g4 + 3] * inv); *(GAS v2u*)(op + 32 * c + 8 * g4) = wv; }
    }
}
static_assert(ATT_LDS <= 139264, "attention LDS");
}

__global__ void __launch_bounds__(NWAVES * 64, 2) mega_fwd(Args args) {
    extern __shared__ __attribute__((aligned(16))) unsigned char lds_raw[];
    LAS unsigned char* lds = (LAS unsigned char*)lds_raw;
    volatile LAS unsigned* MISC = (volatile LAS unsigned*)(lds + MISC_OFF);
    const int tid = threadIdx.x, lane = tid & 63, wave = __builtin_amdgcn_readfirstlane(tid >> 6);
    const int G = gridDim.x, bx = blockIdx.x, vcu = (G % 8 == 0) ? (bx % 8) * (G / 8) + bx / 8 : bx;
    const int gw = vcu * NWAVES + wave, NGW = G * NWAVES;
    unsigned char* ws = args.ws;
    gu32* ctl = (gu32*)(ws + WS_CTL);
    float* ssq = (float*)(ws + WS_SSQ);
    bf16* HB = (bf16*)(ws + WS_HB); bf16* HB2 = (bf16*)(ws + WS_HB2); bf16* ACT = (bf16*)(ws + WS_ACT); bf16* ZQO = (bf16*)(ws + WS_ACT); bf16* PROJ = (bf16*)(ws + WS_PROJ);
    bf16* KP = (bf16*)(ws + WS_KP); bf16* VP = (bf16*)(ws + WS_VP); bf16* KS = (bf16*)(ws + WS_KS); bf16* VS = (bf16*)(ws + WS_VS);
    bf16* PB = (bf16*)(ws + WS_PB); float2* EST = (float2*)(ws + WS_KP);   f32x4* S5L = (f32x4*)(ws + WS_S5L); float* S5B = (float*)(ws + WS_S5B); float* TAB = (float*)(ws + WS_TAB);
    float* Hres = args.out;
    for (int u = tid; u < (LDS_BYTES - MISC_OFF) / 4; u += NWAVES * 64) ((LAS unsigned*)(lds + MISC_OFF))[u] = 0u;
    __syncthreads();
#if MK_ONE_LAUNCH
    XcdBarrier bar = xcd_barrier_post((unsigned*)(ctl + CW_BAR), MISC + 8);
#define GRID_BAR() xcd_barrier(bar)
#else
#define GRID_BAR() do {} while (0)
#endif
    const int lo = args.ph_lo, hi = args.ph_hi;
#define IN(k) (lo <= (k) && (k) < hi)
#define SEAM() GRID_BAR()

    if (IN(0)) {
        LAS float* scr = (LAS float*)(lds + wave * 16384);
        int base = 0;
#pragma unroll
        for (int l = 0; l < 2; ++l) {
            unsigned char* wl = ws + WS_WL + l * WL_STRIDE;
            tr_matrix(args.in[I_F1WG] + (size_t)l * D * FF, D, FF, args.in[I_F1G] + l * D, (bf16*)(wl + WL_1GU), 256, 0, scr, gw, NGW, lane, base);
            tr_matrix(args.in[I_F1WU] + (size_t)l * D * FF, D, FF, args.in[I_F1G] + l * D, (bf16*)(wl + WL_1GU), 256, 128, scr, gw, NGW, lane, base);
            tr_matrix(args.in[I_F1WD] + (size_t)l * D * FF, FF, D, nullptr, (bf16*)(wl + WL_1D), 128, 0, scr, gw, NGW, lane, base, WD_BLOCKED);
            tr_matrix(args.in[I_F2WG] + (size_t)l * D * FF, D, FF, args.in[I_F2G] + l * D, (bf16*)(wl + WL_2GU), 256, 0, scr, gw, NGW, lane, base);
            tr_matrix(args.in[I_F2WU] + (size_t)l * D * FF, D, FF, args.in[I_F2G] + l * D, (bf16*)(wl + WL_2GU), 256, 128, scr, gw, NGW, lane, base);
            tr_matrix(args.in[I_F2WD] + (size_t)l * D * FF, FF, D, nullptr, (bf16*)(wl + WL_2D), 128, 0, scr, gw, NGW, lane, base, WD_BLOCKED);
            tr_matrix(args.in[I_PLWG] + (size_t)l * D * D, D, D, args.in[I_PLG] + l * D, (bf16*)(wl + WL_PG), 128, 0, scr, gw, NGW, lane, base);
            tr_matrix(args.in[I_PLWP] + (size_t)l * PLE * D, PLE, D, nullptr, (bf16*)(wl + WL_PP), 128, 0, scr, gw, NGW, lane, base);
        }
        tr_matrix(args.in[I_GLA], D, D, nullptr, (bf16*)(ws + WS_WGLU), 256, 0, scr, gw, NGW, lane, base);
        tr_matrix(args.in[I_GLB], D, D, nullptr, (bf16*)(ws + WS_WGLU), 256, 128, scr, gw, NGW, lane, base);
        tr_matrix(args.in[I_WK], D, D, args.in[I_KVG], (bf16*)(ws + WS_WKV), 128, 0, scr, gw, NGW, lane, base);
        tr_matrix(args.in[I_WV], D, D, args.in[I_KVG], (bf16*)(ws + WS_WKV), 128, 2048, scr, gw, NGW, lane, base);
        tr_matrix(args.in[I_WQ], D, D, args.in[I_MIXG] + D, (bf16*)(ws + WS_WQ), 128, 0, scr, gw, NGW, lane, base);
        tr_matrix(args.in[I_WO], D, D, nullptr, (bf16*)(ws + WS_WO), 128, 0, scr, gw, NGW, lane, base);
        for (int m = gw; m < M; m += NGW) { const float* src = (m < MP) ? args.in[I_XP] + (size_t)m * D : args.in[I_XS] + (size_t)(m - MP) * D;
            const float s = wave_sum(row2048_to_bf16(src, HB + (size_t)m * LDH, lane)); if (lane == 0) ssq[m] = s; }
        for (int m = gw; m < DB * CROWS; m += NGW) { const int b = m >> 9, t = m & 511;
            (void)row2048_to_bf16(args.in[I_CK] + (size_t)m * D, KS + (size_t)(b * SROWS + t) * D, lane);
            (void)row2048_to_bf16(args.in[I_CV] + (size_t)m * D, VS + (size_t)(b * SROWS + t) * D, lane); }
        for (int m = gw; m < 2 * M; m += NGW) { const int l = m / M, r = m % M;
            const float* src = (r < MP) ? args.in[I_PP] + ((size_t)l * MP + r) * PLE : args.in[I_PS] + ((size_t)l * MS + (r - MP)) * PLE;
            const f32x4 v = ((const GAS f32x4*)src)[lane]; v2u w; w.x = pk2(v[0], v[1]); w.y = pk2(v[2], v[3]); ((GAS v2u*)(PB + (size_t)m * LDPB))[lane] = w; }
        { const int i = gw * 64 + lane;
          if (i < NG * NP) { const int g = i >> 6;
            const double lre = args.in[I_LRE][i], lim = args.in[I_LIM][i], dt = exp((double)args.in[I_LDT][g]);
            const double er = exp(lre * dt), sn = sin(lim * dt), cs = cos(lim * dt), lbr = er * cs, lbi = er * sn;
            const double e128 = exp(lre * dt * 64.0), s128 = sin(lim * dt * 64.0), c128 = cos(lim * dt * 64.0);
            f32x4 lv; lv[0] = (float)lbr; lv[1] = (float)lbi; lv[2] = (float)(e128 * c128); lv[3] = (float)(e128 * s128); S5L[i] = lv;
            const double nr = lbr - 1.0, ni = lbi, den = lre * lre + lim * lim, fr = (nr * lre + ni * lim) / den, fi = (ni * lre - nr * lim) / den;
            for (int c = 0; c < 16; ++c) { const double br = args.in[I_BRE][(size_t)i * 16 + c], bi = args.in[I_BIM][(size_t)i * 16 + c];
                S5B[(size_t)i * 32 + c] = (float)(fr * br - fi * bi); S5B[(size_t)i * 32 + 16 + c] = (float)(fr * bi + fi * br); } } }
        for (int i = gw * 64 + lane; i < NH * 640; i += NGW * 64) { const int hh = i / 640, y = i % 640; int dd = 575 - y; dd = dd < -256 ? -256 : (dd > 256 ? 256 : dd);
            TAB[i] = 1.4426950408889634f * args.in[I_RB][hh * 513 + dd + 256]; }
    }
    SEAM();

    { constexpr int l = 0;

        const int pb = 1 + 10 * l;
        unsigned char* wl = ws + WS_WL + l * WL_STRIDE;
        float* sq = ssq + (size_t)(4 * l) * M;
        if (l == 1 && IN(pb + 0)) {
            pg8::Gemm g{HB2, (const bf16*)(ws + WS_WKV), M, 2 * D, D, LDH, LDH}; pg8::StaticOrder S; S.init(M, 2 * D, G, G - 1 - bx, 64 * MT_N4096);
            pg8::EpiHead<0, MT_N4096> E{sq, args.in[I_KNG], 1.0f, (PG8_LAS float*)(lds + XCH_OFF), KP, KS, VP, VS, args.out + O_PK, args.out + O_PV, args.out + O_SK, args.out + O_SV, 0};
            pg8::gemm_phase<pg8::EpiHead<0, MT_N4096>, pg8::StaticOrder, true, true, MT_N4096>(lds, g, S, E);
        }
        if (IN(pb + 1)) {
            pg8::Gemm g{l == 0 ? HB : HB2, (const bf16*)(wl + WL_1GU), M, 2 * FF, D, LDH, LDH}; pg8::StaticOrder S; S.init(M, 2 * FF, G, bx, 64 * MT_UP);
            pg8::EpiUp<MT_UP> E{ACT, sq, ACT_BLOCKED ? 0 : LDACT};
            pg8::gemm_phase<pg8::EpiUp<MT_UP>, pg8::StaticOrder, true, SP2_UP, MT_UP>(lds, g, S, E);
        }
        if (IN(pb + 2)) {
            int kple = PLE; asm volatile("" : "+s"(kple));
            pg8::Gemm g{PB + (size_t)l * M * LDPB, (const bf16*)(wl + WL_PP), M, D, kple, LDPB, LDPB}; const pg8::RangeOrder S = proj_tail(G, bx, 0);
            pg8::EpiProj<MT_N2048> E{PROJ, D};
            pg8::gemm_phase<pg8::EpiProj<MT_N2048>, pg8::RangeOrder, true, true, MT_N2048>(lds, g, S, E);
        }
        SEAM();
        if (IN(pb + 3)) {
            pg8::Gemm g{ACT, (const bf16*)(wl + WL_1D), M, D, FF, ACT_BLOCKED ? 64 : LDACT, WD_BLOCKED ? 64 : LDACT, ACT_BLOCKED ? ACT_PR * 128 : 0, WD_BLOCKED ? 32768 : 0, ACT_BLOCKED ? (long)(FF / 64) * ACT_PR * 128 : 0L, WD_BLOCKED ? (long)(FF / 64) * 32768 : 0L, ACT_BLOCKED ? ACT_PR * 32 : 0}; pg8::StaticOrder S; S.init(M, D, G, bx, 64 * MT_DOWN, WGM_N2048);
            pg8::EpiRes<0, MT_DOWN, l == 0> E{args.in[I_XP], args.in[I_XS], HB2, nullptr, HB, sq + M, nullptr, nullptr, 0.5f, LDH};
            pg8::gemm_phase<pg8::EpiRes<0, MT_DOWN, l == 0>, pg8::StaticOrder, ALIGN_RES, true, MT_DOWN>(lds, g, S, E);
        }
        SEAM();
        if (IN(pb + 4)) {
            if (l == 0) s5_mfma<true>(HB, sq + M, args.in[I_MIXG], S5L, S5B, args.in[I_CRE], args.in[I_CIM], args.in[I_SD], EST, args.in[I_SRE], args.in[I_SIM], ZQO,
                                  args.out + O_PSRE, args.out + O_PSIM, args.out + O_SSRE, args.out + O_SSIM, (LAS char*)(lds + wave * S5_WAVE_LDS), gw, NGW, lane, true);
            else { pg8::Gemm g{HB, (const bf16*)(ws + WS_WQ), M, D, D, LDH, LDH}; pg8::StaticOrder S; S.init(M, D, G, bx, 64 * MT_N2048, WGM_N2048);
                pg8::EpiHead<1, MT_N2048> E{sq + M, args.in[I_QNG], 0.08838834764831845f * 1.4426950408889634f, (PG8_LAS float*)(lds + XCH_OFF), ZQO, nullptr, nullptr, nullptr, nullptr, nullptr, nullptr, nullptr, LDH};
                pg8::gemm_phase<pg8::EpiHead<1, MT_N2048>, pg8::StaticOrder, true, true, MT_N2048>(lds, g, S, E); }
        }
        SEAM();
        if (l == 0) { if (IN(21)) s5_prefix(S5L, EST, gw, NGW, lane); SEAM(); }
        if (IN(pb + 5)) {
            if (l == 0) s5_mfma<true>(HB, sq + M, args.in[I_MIXG], S5L, S5B, args.in[I_CRE], args.in[I_CIM], args.in[I_SD], EST, args.in[I_SRE], args.in[I_SIM], ZQO,
                                  args.out + O_PSRE, args.out + O_PSIM, args.out + O_SSRE, args.out + O_SSIM, (LAS char*)(lds + wave * S5_WAVE_LDS), gw, NGW, lane, false);
            else {
                for (int ui = vcu; ui < 1024 + 512; ui += G) {
                    if (ui < 1024) { const int qb = ui & 15, hh = (ui >> 4) & 15, b = ui >> 8;
                        att::attn_unit((LAS char*)lds, ZQO, (size_t)b * SEQ + 256 * qb, KP + (size_t)b * SEQ * D, VP + (size_t)b * SEQ * D, hh, 4 * qb, 4, TAB + hh * 640, HB2, tid); }
                    else { const int u2 = ui - 1024, hh = u2 & 15, b = u2 >> 4;
                        att::attn_unit((LAS char*)lds, ZQO, (size_t)MP + b * DSEQ, KS + (size_t)b * SROWS * D, VS + (size_t)b * SROWS * D, hh, 8, 1, TAB + hh * 640, HB2, tid); }
                }
            }
        }
        SEAM();
        if (IN(pb + 6)) {
            if (l == 0) { pg8::Gemm g{ZQO, (const bf16*)(ws + WS_WGLU), M, 2 * D, D, LDH, LDH}; pg8::StaticOrder S; S.init(M, 2 * D, G, bx, 64 * MT_N4096);
                pg8::EpiRes<1, MT_N4096, false> E{nullptr, nullptr, HB, nullptr, HB, sq + 2 * M, nullptr, nullptr, 1.0f, LDH};
                pg8::gemm_phase<pg8::EpiRes<1, MT_N4096, false>, pg8::StaticOrder, ALIGN_RES, true, MT_N4096>(lds, g, S, E); }
            else { pg8::Gemm g{HB2, (const bf16*)(ws + WS_WO), M, D, D, LDH, LDH}; pg8::StaticOrder S; S.init(M, D, G, bx, 64 * MT_N2048, WGM_N2048);
                pg8::EpiRes<0, MT_N2048, false> E{nullptr, nullptr, HB, nullptr, HB, sq + 2 * M, nullptr, nullptr, 1.0f, LDH};
                pg8::gemm_phase<pg8::EpiRes<0, MT_N2048, false>, pg8::StaticOrder, ALIGN_RES, true, MT_N2048>(lds, g, S, E); }
        }
        SEAM();
        if (IN(pb + 7)) {
            pg8::Gemm g{HB, (const bf16*)(wl + WL_2GU), M, 2 * FF, D, LDH, LDH}; pg8::StaticOrder S; S.init(M, 2 * FF, G, bx, 64 * MT_UP);
            pg8::EpiUp<MT_UP> E{ACT, sq + 2 * M, ACT_BLOCKED ? 0 : LDACT};
            pg8::gemm_phase<pg8::EpiUp<MT_UP>, pg8::StaticOrder, true, SP2_UP, MT_UP>(lds, g, S, E);
        }
        if (IN(22 + l)) {
            int kple = PLE; asm volatile("" : "+s"(kple));
            pg8::Gemm g{PB + (size_t)l * M * LDPB, (const bf16*)(wl + WL_PP), M, D, kple, LDPB, LDPB}; const pg8::RangeOrder S = proj_tail(G, bx, 1);
            pg8::EpiProj<MT_N2048> E{PROJ, D};
            pg8::gemm_phase<pg8::EpiProj<MT_N2048>, pg8::RangeOrder, true, true, MT_N2048>(lds, g, S, E);
        }
        SEAM();
        if (IN(pb + 8)) {
            pg8::Gemm g{ACT, (const bf16*)(wl + WL_2D), M, D, FF, ACT_BLOCKED ? 64 : LDACT, WD_BLOCKED ? 64 : LDACT, ACT_BLOCKED ? ACT_PR * 128 : 0, WD_BLOCKED ? 32768 : 0, ACT_BLOCKED ? (long)(FF / 64) * ACT_PR * 128 : 0L, WD_BLOCKED ? (long)(FF / 64) * 32768 : 0L, ACT_BLOCKED ? ACT_PR * 32 : 0}; pg8::StaticOrder S; S.init(M, D, G, bx, 64 * MT_DOWN, WGM_N2048);
            pg8::EpiRes<0, MT_DOWN, false> E{nullptr, nullptr, HB, nullptr, HB, sq + 3 * M, nullptr, nullptr, 0.5f, LDH};
            pg8::gemm_phase<pg8::EpiRes<0, MT_DOWN, false>, pg8::StaticOrder, ALIGN_RES, true, MT_DOWN>(lds, g, S, E);
        }
        SEAM();
        if (IN(pb + 9)) {
            pg8::Gemm g{HB, (const bf16*)(wl + WL_PG), M, D, D, LDH, LDH}; pg8::StaticOrder S; S.init(M, D, G, bx, 64 * MT_N2048, WGM_N2048);
            pg8::EpiRes<2, MT_N2048, false> E{nullptr, nullptr, HB, l == 0 ? nullptr : Hres, l == 0 ? HB2 : nullptr, l == 0 ? sq + 4 * M : nullptr, sq + 3 * M, PROJ, 1.0f, LDH};
            pg8::gemm_phase<pg8::EpiRes<2, MT_N2048, false>, pg8::StaticOrder, ALIGN_RES, true, MT_N2048>(lds, g, S, E);
        }
        if (l == 0) SEAM();
        }
    { constexpr int l = 1;

        const int pb = 1 + 10 * l;
        unsigned char* wl = ws + WS_WL + l * WL_STRIDE;
        float* sq = ssq + (size_t)(4 * l) * M;
        if (l == 1 && IN(pb + 0)) {
            pg8::Gemm g{HB2, (const bf16*)(ws + WS_WKV), M, 2 * D, D, LDH, LDH}; pg8::StaticOrder S; S.init(M, 2 * D, G, G - 1 - bx, 64 * MT_N4096);
            pg8::EpiHead<0, MT_N4096> E{sq, args.in[I_KNG], 1.0f, (PG8_LAS float*)(lds + XCH_OFF), KP, KS, VP, VS, args.out + O_PK, args.out + O_PV, args.out + O_SK, args.out + O_SV, 0};
            pg8::gemm_phase<pg8::EpiHead<0, MT_N4096>, pg8::StaticOrder, true, true, MT_N4096>(lds, g, S, E);
        }
        if (IN(pb + 1)) {
            pg8::Gemm g{l == 0 ? HB : HB2, (const bf16*)(wl + WL_1GU), M, 2 * FF, D, LDH, LDH}; pg8::StaticOrder S; S.init(M, 2 * FF, G, bx, 64 * MT_UP);
            pg8::EpiUp<MT_UP> E{ACT, sq, ACT_BLOCKED ? 0 : LDACT};
            pg8::gemm_phase<pg8::EpiUp<MT_UP>, pg8::StaticOrder, true, SP2_UP, MT_UP>(lds, g, S, E);
        }
        if (IN(pb + 2)) {
            int kple = PLE; asm volatile("" : "+s"(kple));
            pg8::Gemm g{PB + (size_t)l * M * LDPB, (const bf16*)(wl + WL_PP), M, D, kple, LDPB, LDPB}; const pg8::RangeOrder S = proj_tail(G, bx, 0);
            pg8::EpiProj<MT_N2048> E{PROJ, D};
            pg8::gemm_phase<pg8::EpiProj<MT_N2048>, pg8::RangeOrder, true, true, MT_N2048>(lds, g, S, E);
        }
        SEAM();
        if (IN(pb + 3)) {
            pg8::Gemm g{ACT, (const bf16*)(wl + WL_1D), M, D, FF, ACT_BLOCKED ? 64 : LDACT, WD_BLOCKED ? 64 : LDACT, ACT_BLOCKED ? ACT_PR * 128 : 0, WD_BLOCKED ? 32768 : 0, ACT_BLOCKED ? (long)(FF / 64) * ACT_PR * 128 : 0L, WD_BLOCKED ? (long)(FF / 64) * 32768 : 0L, ACT_BLOCKED ? ACT_PR * 32 : 0}; pg8::StaticOrder S; S.init(M, D, G, bx, 64 * MT_DOWN, WGM_N2048);
            pg8::EpiRes<0, MT_DOWN, l == 0> E{args.in[I_XP], args.in[I_XS], HB2, nullptr, HB, sq + M, nullptr, nullptr, 0.5f, LDH};
            pg8::gemm_phase<pg8::EpiRes<0, MT_DOWN, l == 0>, pg8::StaticOrder, ALIGN_RES, true, MT_DOWN>(lds, g, S, E);
        }
        SEAM();
        if (IN(pb + 4)) {
            if (l == 0) s5_mfma<true>(HB, sq + M, args.in[I_MIXG], S5L, S5B, args.in[I_CRE], args.in[I_CIM], args.in[I_SD], EST, args.in[I_SRE], args.in[I_SIM], ZQO,
                                  args.out + O_PSRE, args.out + O_PSIM, args.out + O_SSRE, args.out + O_SSIM, (LAS char*)(lds + wave * S5_WAVE_LDS), gw, NGW, lane, true);
            else { pg8::Gemm g{HB, (const bf16*)(ws + WS_WQ), M, D, D, LDH, LDH}; pg8::StaticOrder S; S.init(M, D, G, bx, 64 * MT_N2048, WGM_N2048);
                pg8::EpiHead<1, MT_N2048> E{sq + M, args.in[I_QNG], 0.08838834764831845f * 1.4426950408889634f, (PG8_LAS float*)(lds + XCH_OFF), ZQO, nullptr, nullptr, nullptr, nullptr, nullptr, nullptr, nullptr, LDH};
                pg8::gemm_phase<pg8::EpiHead<1, MT_N2048>, pg8::StaticOrder, true, true, MT_N2048>(lds, g, S, E); }
        }
        SEAM();
        if (l == 0) { if (IN(21)) s5_prefix(S5L, EST, gw, NGW, lane); SEAM(); }
        if (IN(pb + 5)) {
            if (l == 0) s5_mfma<true>(HB, sq + M, args.in[I_MIXG], S5L, S5B, args.in[I_CRE], args.in[I_CIM], args.in[I_SD], EST, args.in[I_SRE], args.in[I_SIM], ZQO,
                                  args.out + O_PSRE, args.out + O_PSIM, args.out + O_SSRE, args.out + O_SSIM, (LAS char*)(lds + wave * S5_WAVE_LDS), gw, NGW, lane, false);
            else {
                for (int ui = vcu; ui < 1024 + 512; ui += G) {
                    if (ui < 1024) { const int qb = ui & 15, hh = (ui >> 4) & 15, b = ui >> 8;
                        att::attn_unit((LAS char*)lds, ZQO, (size_t)b * SEQ + 256 * qb, KP + (size_t)b * SEQ * D, VP + (size_t)b * SEQ * D, hh, 4 * qb, 4, TAB + hh * 640, HB2, tid); }
                    else { const int u2 = ui - 1024, hh = u2 & 15, b = u2 >> 4;
                        att::attn_unit((LAS char*)lds, ZQO, (size_t)MP + b * DSEQ, KS + (size_t)b * SROWS * D, VS + (size_t)b * SROWS * D, hh, 8, 1, TAB + hh * 640, HB2, tid); }
                }
            }
        }
        SEAM();
        if (IN(pb + 6)) {
            if (l == 0) { pg8::Gemm g{ZQO, (const bf16*)(ws + WS_WGLU), M, 2 * D, D, LDH, LDH}; pg8::StaticOrder S; S.init(M, 2 * D, G, bx, 64 * MT_N4096);
                pg8::EpiRes<1, MT_N4096, false> E{nullptr, nullptr, HB, nullptr, HB, sq + 2 * M, nullptr, nullptr, 1.0f, LDH};
                pg8::gemm_phase<pg8::EpiRes<1, MT_N4096, false>, pg8::StaticOrder, ALIGN_RES, true, MT_N4096>(lds, g, S, E); }
            else { pg8::Gemm g{HB2, (const bf16*)(ws + WS_WO), M, D, D, LDH, LDH}; pg8::StaticOrder S; S.init(M, D, G, bx, 64 * MT_N2048, WGM_N2048);
                pg8::EpiRes<0, MT_N2048, false> E{nullptr, nullptr, HB, nullptr, HB, sq + 2 * M, nullptr, nullptr, 1.0f, LDH};
                pg8::gemm_phase<pg8::EpiRes<0, MT_N2048, false>, pg8::StaticOrder, ALIGN_RES, true, MT_N2048>(lds, g, S, E); }
        }
        SEAM();
        if (IN(pb + 7)) {
            pg8::Gemm g{HB, (const bf16*)(wl + WL_2GU), M, 2 * FF, D, LDH, LDH}; pg8::StaticOrder S; S.init(M, 2 * FF, G, bx, 64 * MT_UP);
            pg8::EpiUp<MT_UP> E{ACT, sq + 2 * M, ACT_BLOCKED ? 0 : LDACT};
            pg8::gemm_phase<pg8::EpiUp<MT_UP>, pg8::StaticOrder, true, SP2_UP, MT_UP>(lds, g, S, E);
        }
        if (IN(22 + l)) {
            int kple = PLE; asm volatile("" : "+s"(kple));
            pg8::Gemm g{PB + (size_t)l * M * LDPB, (const bf16*)(wl + WL_PP), M, D, kple, LDPB, LDPB}; const pg8::RangeOrder S = proj_tail(G, bx, 1);
            pg8::EpiProj<MT_N2048> E{PROJ, D};
            pg8::gemm_phase<pg8::EpiProj<MT_N2048>, pg8::RangeOrder, true, true, MT_N2048>(lds, g, S, E);
        }
        SEAM();
        if (IN(pb + 8)) {
            pg8::Gemm g{ACT, (const bf16*)(wl + WL_2D), M, D, FF, ACT_BLOCKED ? 64 : LDACT, WD_BLOCKED ? 64 : LDACT, ACT_BLOCKED ? ACT_PR * 128 : 0, WD_BLOCKED ? 32768 : 0, ACT_BLOCKED ? (long)(FF / 64) * ACT_PR * 128 : 0L, WD_BLOCKED ? (long)(FF / 64) * 32768 : 0L, ACT_BLOCKED ? ACT_PR * 32 : 0}; pg8::StaticOrder S; S.init(M, D, G, bx, 64 * MT_DOWN, WGM_N2048);
            pg8::EpiRes<0, MT_DOWN, false> E{nullptr, nullptr, HB, nullptr, HB, sq + 3 * M, nullptr, nullptr, 0.5f, LDH};
            pg8::gemm_phase<pg8::EpiRes<0, MT_DOWN, false>, pg8::StaticOrder, ALIGN_RES, true, MT_DOWN>(lds, g, S, E);
        }
        SEAM();
        if (IN(pb + 9)) {
            pg8::Gemm g{HB, (const bf16*)(wl + WL_PG), M, D, D, LDH, LDH}; pg8::StaticOrder S; S.init(M, D, G, bx, 64 * MT_N2048, WGM_N2048);
            pg8::EpiRes<2, MT_N2048, false> E{nullptr, nullptr, HB, l == 0 ? nullptr : Hres, l == 0 ? HB2 : nullptr, l == 0 ? sq + 4 * M : nullptr, sq + 3 * M, PROJ, 1.0f, LDH};
            pg8::gemm_phase<pg8::EpiRes<2, MT_N2048, false>, pg8::StaticOrder, ALIGN_RES, true, MT_N2048>(lds, g, S, E);
        }
        if (l == 0) SEAM();
        }
#undef IN
#undef SEAM
}

extern "C" void kernel_launch(void* const* d_in, const int* in_sizes, int n_in, void* d_out, int out_size, void* d_ws, size_t ws_size, hipStream_t stream) {
    static int grid = 0;
    if (grid == 0) {
        if (n_in != 38 || out_size != (int)O_END || ws_size < WS_END) { fprintf(stderr, "kernel_launch: unexpected shapes (n_in %d, out %d, ws %zu)\n", n_in, out_size, ws_size); grid = -1; return; }
        int dev = 0, cus = 0, per_cu = 0;
        if (hipGetDevice(&dev) != hipSuccess || hipDeviceGetAttribute(&cus, hipDeviceAttributeMultiprocessorCount, dev) != hipSuccess) { grid = -1; return; }
        if (hipFuncSetAttribute((const void*)mega_fwd, hipFuncAttributeMaxDynamicSharedMemorySize, LDS_BYTES) != hipSuccess) { fprintf(stderr, "kernel_launch: hipFuncSetAttribute failed\n"); grid = -1; return; }
        if (hipOccupancyMaxActiveBlocksPerMultiprocessor(&per_cu, (const void*)mega_fwd, NWAVES * 64, LDS_BYTES) != hipSuccess || per_cu < 1) { fprintf(stderr, "kernel_launch: occupancy query says %d\n", per_cu); }
        (void)hipGetLastError();
        grid = cus;
    }
    if (grid < 0) return;
    if (hipMemsetAsync((char*)d_ws + WS_CTL, 0, CTL_ZERO_BYTES, stream) != hipSuccess) return;
    Args a{};
    for (int i = 0; i < 38; ++i) a.in[i] = (const float*)d_in[i];
    a.out = (float*)d_out; a.ws = (unsigned char*)d_ws;
#if MK_ONE_LAUNCH
    a.ph_lo = 0; a.ph_hi = N_PHASES;
    hipLaunchKernelGGL(mega_fwd, dim3(grid), dim3(NWAVES * 64), LDS_BYTES, stream, a);
#else
    static const int order[23] = {0, 2, 3, 4, 5, 21, 6, 7, 8, 22, 9, 10, 11, 12, 13, 14, 15, 16, 17, 18, 23, 19, 20};
    for (int oi = 0; oi < 23; ++oi) { const int p = order[oi]; a.ph_lo = p; a.ph_hi = p + 1; int reps = 1;
        for (int r = 0; r < reps; ++r) hipLaunchKernelGGL(mega_fwd, dim3(grid), dim3(NWAVES * 64), LDS_BYTES, stream, a); }
#endif
}
```

```cpp
#include <hip/hip_runtime.h>
#include <cstdio>
#include <cstdint>
namespace pg8 {
#define PG8_LAS __attribute__((address_space(3)))
typedef unsigned short bf16_t;
typedef short bf16x8 __attribute__((ext_vector_type(8)));
typedef float f32x4 __attribute__((ext_vector_type(4)));
typedef unsigned u32x4 __attribute__((ext_vector_type(4)));
constexpr int BM = 256, BK = 64, HALF = 128, HTB = HALF * BK * 2  , STAGE_BYTES = 8 * HTB, NXCD = 8, WGM = 8;

__host__ __device__ __forceinline__ int lds_byte(int r, int c) { const int st = (r >> 4) * 2 + (c >> 5), rr = r & 15, cc = c & 31, ob = rr * 64 + cc * 2; return st * 1024 + (ob ^ (((ob >> 9) & 1) << 5)); }
__host__ __device__ __forceinline__ void stage_rc(int b, int& R, int& C) { const int st = b / 1024, sb = b % 1024, swz = sb ^ (((sb >> 9) & 1) << 5); R = (st >> 1) * 16 + swz / 64; C = (st & 1) * 32 + (swz % 64) / 2; }
__host__ __device__ __forceinline__ int perm32(int rho) { const int n = rho >> 4, i = rho & 15; return 8 * (i >> 2) + 4 * n + (i & 3); }

struct Unit { int pm, pn; };
struct Gemm { const bf16_t* A; const bf16_t* Bt; int M, N, K, lda, ldb; int ksA = 0, ksB = 0; long tsA = 0, tsB = 0; int sbA = 0; };

struct RangeOrder {
    int first, count, nN;
    __host__ __device__ bool next(int i, Unit& u) const { if (i >= count) return false; const int id = first + i; u.pm = id / nN; u.pn = id - u.pm * nN; return true; }
    __device__ __forceinline__ void a_ready(const Unit&) const {}
    __device__ __forceinline__ void done(const Unit&) const {}
};
struct StaticOrder {
    int nM, nN, nwg, G, c, wgm;
    __host__ __device__ void init(int M, int N, int G_, int c_, int bm = BM, int wgm_ = WGM) { nM = M / bm; nN = N / BM; nwg = nM * nN; G = G_; c = c_; wgm = wgm_; }
    __host__ __device__ bool next(int i, Unit& u) const {
        const long L = (long)i * G + c; if (L >= nwg) return false;
        int wgid = (int)L; { const int q = nwg / NXCD, r = nwg % NXCD, xcd = wgid % NXCD, off = wgid / NXCD; wgid = (xcd < r ? xcd * (q + 1) : r * (q + 1) + (xcd - r) * q) + off; }
        const int nig = wgm * nN, gid = wgid / nig, fm = gid * wgm, gsz = (nM - fm) < wgm ? (nM - fm) : wgm;
        u.pm = fm + ((wgid % nig) % gsz); u.pn = (wgid % nig) / gsz; return true;
    }
    __device__ __forceinline__ void a_ready(const Unit&) const {}
    __device__ __forceinline__ void done(const Unit&) const {}
};

typedef float f32x2 __attribute__((ext_vector_type(2)));
typedef unsigned u32x2 __attribute__((ext_vector_type(2)));
typedef __bf16 bf16x2_t __attribute__((ext_vector_type(2)));
__device__ __forceinline__ unsigned cvt_pk_bf16(float lo, float hi) { f32x2 v = {lo, hi}; bf16x2_t b = __builtin_convertvector(v, bf16x2_t); return __builtin_bit_cast(unsigned, b); }
__device__ __forceinline__ float sigm(float x) { return __builtin_amdgcn_rcpf(1.0f + __builtin_amdgcn_exp2f(-1.4426950408889634f * x)); }
__device__ __forceinline__ f32x4 sigm4(f32x4 x) { f32x4 r; r[0] = sigm(x[0]); r[1] = sigm(x[1]); r[2] = sigm(x[2]); r[3] = sigm(x[3]); return r; }
constexpr int MTOK = 18432, MPROMPT = 16384, DM = 2048, FFH = 5632;
#ifndef ACT_PR
#define ACT_PR 192
#endif
constexpr float RMS_EPS = 1e-6f;

template <int MT> struct EpiUp {
    static constexpr bool PERM = true, AFTER_DRAIN = false;
    bf16_t* O; const float* ssq; int ldo;
    __device__ __forceinline__ void operator()(const f32x4 (&acc)[2][2][MT][2], const Unit& u, int wr, int wc, int fr, int fq) const {
        const int row0 = u.pm * (64 * MT) + wr * (16 * MT) + fr, col0 = u.pn * HALF + wc * 32 + 8 * fq;
        float sv[2][MT];
#pragma unroll
        for (int ai = 0; ai < 2; ++ai)
#pragma unroll
            for (int m = 0; m < MT; ++m) sv[ai][m] = ssq[row0 + ai * (32 * MT) + m * 16];
#pragma unroll
        for (int ai = 0; ai < 2; ++ai)
#pragma unroll
            for (int m = 0; m < MT; ++m) {
                const int row = row0 + ai * (32 * MT) + m * 16;
                const float rs = rsqrtf(sv[ai][m] * (1.0f / 2048.0f) + RMS_EPS);
                const f32x4 g0 = acc[ai][0][m][0] * rs, g1 = acc[ai][0][m][1] * rs, u0 = acc[ai][1][m][0] * rs, u1 = acc[ai][1][m][1] * rs;
                const f32x4 o0 = g0 * sigm4(g0) * u0, o1 = g1 * sigm4(g1) * u1;
                u32x4 w; w.x = cvt_pk_bf16(o0[0], o0[1]); w.y = cvt_pk_bf16(o0[2], o0[3]); w.z = cvt_pk_bf16(o1[0], o1[1]); w.w = cvt_pk_bf16(o1[2], o1[3]);
                if (ldo) *(u32x4*)(O + (size_t)row * ldo + col0) = w;
                else { const int pnl = row / ACT_PR, rr = row - pnl * ACT_PR;
                    *(u32x4*)((char*)O + (size_t)pnl * ((FFH / 32) * ACT_PR * 64) + (size_t)(col0 >> 5) * (ACT_PR * 64) + rr * 64 + (col0 & 31) * 2) = w; }
            }
    }
};
template <int MT> struct EpiProj {
    static constexpr bool PERM = true, AFTER_DRAIN = false;
    bf16_t* O; int ldo;
    __device__ __forceinline__ void operator()(const f32x4 (&acc)[2][2][MT][2], const Unit& u, int wr, int wc, int fr, int fq) const {
        const int row0 = u.pm * (64 * MT) + wr * (16 * MT) + fr, col0 = u.pn * BM + wc * 32 + 8 * fq;
#pragma unroll
        for (int ai = 0; ai < 2; ++ai)
#pragma unroll
            for (int m = 0; m < MT; ++m) {
                bf16_t* rowp = O + (size_t)(row0 + ai * (32 * MT) + m * 16) * ldo + col0;
#pragma unroll
                for (int bj = 0; bj < 2; ++bj) { const f32x4 v0 = acc[ai][bj][m][0], v1 = acc[ai][bj][m][1];
                    u32x4 w; w.x = cvt_pk_bf16(v0[0], v0[1]); w.y = cvt_pk_bf16(v0[2], v0[3]); w.z = cvt_pk_bf16(v1[0], v1[1]); w.w = cvt_pk_bf16(v1[2], v1[3]);
                    *(u32x4*)(rowp + bj * HALF) = w; }
            }
    }
};
__device__ __forceinline__ f32x4 bf4_to_f32(u32x2 w) { f32x4 v; v[0] = __uint_as_float(w.x << 16); v[1] = __uint_as_float(w.x & 0xffff0000u); v[2] = __uint_as_float(w.y << 16); v[3] = __uint_as_float(w.y & 0xffff0000u); return v; }
template <int MODE, int MT, bool BASEF32> struct EpiRes {
    static constexpr bool PERM = true, AFTER_DRAIN = false;
    const float* baseP; const float* baseS; const bf16_t* baseHb; float* outH; bf16_t* outHb; float* ssq_out; const float* ssq_in; const bf16_t* proj; float scale; int ldhb;
    __device__ __forceinline__ void operator()(const f32x4 (&acc)[2][2][MT][2], const Unit& u, int wr, int wc, int fr, int fq) const {
        asm volatile("" : "+v"(fr), "+v"(fq));
        constexpr int NB = (MODE == 1) ? 1 : 2;
        constexpr int MB = (MT == 4) ? 2 : ((MODE == 2) ? 1 : 3);
        const int row0 = u.pm * (64 * MT) + wr * (16 * MT) + fr;
        const int col0 = (MODE == 1 ? u.pn * HALF : u.pn * BM) + wc * 32 + 8 * fq;
#pragma unroll
        for (int ai = 0; ai < 2; ++ai)
#pragma unroll
            for (int mb = 0; mb < MT; mb += MB) {
                f32x4 hb[MB][NB][2]; u32x4 hw[MB][NB]; u32x4 pj[MB][NB]; float sv[MB];
#pragma unroll
                for (int mm = 0; mm < MB; ++mm) {
                    const int row = row0 + ai * (32 * MT) + (mb + mm) * 16;
                    if (MODE == 2) sv[mm] = ssq_in[row];
#pragma unroll
                    for (int bj = 0; bj < NB; ++bj) { const int cc = col0 + bj * HALF;
                        if (BASEF32) { const float* xp = (row < MPROMPT ? baseP : baseS - (size_t)MPROMPT * DM) + (size_t)row * DM + cc; hb[mm][bj][0] = *(const f32x4*)xp; hb[mm][bj][1] = *(const f32x4*)(xp + 4); }
                        else hw[mm][bj] = *(const u32x4*)(baseHb + (size_t)row * ldhb + cc);
                        if (MODE == 2) pj[mm][bj] = *(const u32x4*)(proj + (size_t)row * DM + cc); }
                }
#pragma unroll
                for (int mm = 0; mm < MB; ++mm) {
                    const int m = mb + mm, row = row0 + ai * (32 * MT) + m * 16;
                    float rs = 1.f; if (MODE == 2) rs = rsqrtf(sv[mm] * (1.0f / 2048.0f) + RMS_EPS);
                    float s = 0.f;
#pragma unroll
                    for (int bj = 0; bj < NB; ++bj) {
                        const int cc = col0 + bj * HALF;
                        f32x4 hn[2];
#pragma unroll
                        for (int n = 0; n < 2; ++n) {
                            f32x4 val;
                            if (MODE == 0) val = acc[ai][bj][m][n] * scale;
                            else if (MODE == 1) val = acc[ai][0][m][n] * sigm4(acc[ai][1][m][n]);
                            else { u32x2 pw; pw.x = n ? pj[mm][bj].z : pj[mm][bj].x; pw.y = n ? pj[mm][bj].w : pj[mm][bj].y; val = bf4_to_f32(pw) * sigm4(acc[ai][bj][m][n] * rs); }
                            f32x4 bs;
                            if (BASEF32) bs = hb[mm][bj][n];
                            else { u32x2 bw; bw.x = n ? hw[mm][bj].z : hw[mm][bj].x; bw.y = n ? hw[mm][bj].w : hw[mm][bj].y; bs = bf4_to_f32(bw); }
                            hn[n] = bs + val;
                            s += (hn[n][0] * hn[n][0] + hn[n][1] * hn[n][1]) + (hn[n][2] * hn[n][2] + hn[n][3] * hn[n][3]);
                        }
                        if (outH) { float* op = outH + (size_t)row * DM + cc; *(f32x4*)op = hn[0]; *(f32x4*)(op + 4) = hn[1]; }
                        if (outHb) { u32x4 w; w.x = cvt_pk_bf16(hn[0][0], hn[0][1]); w.y = cvt_pk_bf16(hn[0][2], hn[0][3]); w.z = cvt_pk_bf16(hn[1][0], hn[1][1]); w.w = cvt_pk_bf16(hn[1][2], hn[1][3]);
                            *(u32x4*)(outHb + (size_t)row * ldhb + cc) = w; }
                    }
                    if (ssq_out) { s += __shfl_xor(s, 16); s += __shfl_xor(s, 32); if (fq == 0) unsafeAtomicAdd(ssq_out + row, s); }
                }
                asm volatile("" ::: "memory");
            }
    }
};
template <int KIND, int MT> struct EpiHead {
    static constexpr bool PERM = true, AFTER_DRAIN = false;
    const float* ssq_in; const float* gain; float qscale; PG8_LAS float* xch;
    bf16_t* kP; bf16_t* kS; bf16_t* vP; bf16_t* vS; float* o_pk; float* o_pv; float* o_sk; float* o_sv; int ldq;
    __device__ __forceinline__ void operator()(const f32x4 (&acc)[2][2][MT][2], const Unit& u, int wr, int wc, int fr, int fq) const {
        asm volatile("" : "+v"(fr), "+v"(fq));
        const bool isV = (KIND == 0) && (u.pn >= 8);
        const int rl0 = wr * (16 * MT) + fr;
#pragma unroll
        for (int ai = 0; ai < 2; ++ai)
#pragma unroll
            for (int m = 0; m < MT; ++m) {
                const int rl = rl0 + ai * (32 * MT) + m * 16;

#pragma unroll
                for (int bj = 0; bj < 2; ++bj) {
                    const f32x4 a = acc[ai][bj][m][0], b = acc[ai][bj][m][1];
                    float s = (a[0] * a[0] + a[1] * a[1]) + (a[2] * a[2] + a[3] * a[3]) + (b[0] * b[0] + b[1] * b[1]) + (b[2] * b[2] + b[3] * b[3]);
                    s += __shfl_xor(s, 16); s += __shfl_xor(s, 32);
                    if (fq == 0) xch[(bj * 256 + rl) * 4 + wc] = s;
                }
            }
        asm volatile("s_waitcnt lgkmcnt(0)" ::: "memory"); __builtin_amdgcn_s_barrier(); asm volatile("" ::: "memory");
        const int cw = wc * 32 + 8 * fq;
        const int ct = (u.pn & 7) * BM + cw;
        float sv[2][MT];
#pragma unroll
        for (int ai = 0; ai < 2; ++ai)
#pragma unroll
            for (int m = 0; m < MT; ++m) sv[ai][m] = ssq_in[u.pm * (64 * MT) + rl0 + ai * (32 * MT) + m * 16];
#pragma unroll
        for (int ai = 0; ai < 2; ++ai)
#pragma unroll
            for (int m = 0; m < MT; ++m) {
                const int rl = rl0 + ai * (32 * MT) + m * 16, row = u.pm * (64 * MT) + rl;
                const float rs = rsqrtf(sv[ai][m] * (1.0f / 2048.0f) + RMS_EPS);
                bf16_t* dst; float* fdst = nullptr;
                if (KIND == 1) dst = kP + (size_t)row * ldq;
                else if (row < MPROMPT) { dst = (isV ? vP : kP) + (size_t)row * DM; const int t = row & 4095; if (t >= 3584) fdst = (isV ? o_pv : o_pk) + (size_t)((row >> 12) * 512 + t - 3584) * DM; }
                else { const int r2 = row - MPROMPT; dst = (isV ? vS : kS) + (size_t)((r2 >> 6) * 576 + 512 + (r2 & 63)) * DM; fdst = (isV ? o_sv : o_sk) + (size_t)r2 * DM; }
#pragma unroll
                for (int bj = 0; bj < 2; ++bj) {
                    const f32x4 ps = *(const PG8_LAS f32x4*)(xch + (bj * 256 + rl) * 4);
                    float sc = rs;
                    if (!isV) { const float ss = ((ps[0] + ps[1]) + (ps[2] + ps[3])) * rs * rs; sc = rs * rsqrtf(ss * (1.0f / 128.0f) + RMS_EPS) * qscale; }
                    f32x4 v0 = acc[ai][bj][m][0] * sc, v1 = acc[ai][bj][m][1] * sc;
                    if (!isV) { v0 = v0 * *(const f32x4*)(gain + cw); v1 = v1 * *(const f32x4*)(gain + cw + 4); }
                    u32x4 w; w.x = cvt_pk_bf16(v0[0], v0[1]); w.y = cvt_pk_bf16(v0[2], v0[3]); w.z = cvt_pk_bf16(v1[0], v1[1]); w.w = cvt_pk_bf16(v1[2], v1[3]);
                    *(u32x4*)(dst + ct + bj * HALF) = w;
                    if (KIND == 0 && fdst) { *(f32x4*)(fdst + ct + bj * HALF) = v0; *(f32x4*)(fdst + ct + bj * HALF + 4) = v1; }
                }
            }
    }
};
template <class Epi, class Sched, bool ALIGN_EPI = false, bool SP2 = false, int MT = 4>
__device__ __forceinline__ void gemm_phase(PG8_LAS unsigned char* lds, const Gemm g, const Sched& S, const Epi& E) {
    int tid = threadIdx.x; asm volatile("" : "+v"(tid));
    const int wid = __builtin_amdgcn_readfirstlane(tid >> 6), lane = tid & 63, wr = wid >> 2, wc = wid & 3, fr = lane & 15, fq = lane >> 4;
    const int K = g.K, nt = K / BK, lda = g.lda, ldb = g.ldb; constexpr int HA = 32 * MT;
    unsigned voffA[2], voffB[2];
#pragma unroll
    for (int i = 0; i < 2; ++i) { int R, C; stage_rc(tid * 16 + i * 8192, R, C); const int Rb = Epi::PERM ? ((R & ~31) + perm32(R & 31)) : R;
        const int Ra = (R >= HA) ? R - 32 : R; voffA[i] = g.sbA ? (unsigned)((C >> 5) * g.sbA + Ra * 32 + (C & 31)) * 2u : (unsigned)(Ra * lda + C) * 2u; voffB[i] = (unsigned)(Rb * ldb + C) * 2u; }
    const size_t kstepA = g.ksA ? (size_t)g.ksA : (size_t)(BK * 2), kstepB = g.ksB ? (size_t)g.ksB : (size_t)(BK * 2);
    const size_t hstepA = g.sbA ? (size_t)HA * 64 : (size_t)HA * lda * 2, hstepB = (size_t)HALF * ldb * 2;
    const size_t tstepA = g.tsA ? (size_t)g.tsA : 2 * hstepA, tstepB = g.tsB ? (size_t)g.tsB : 2 * hstepB;
    const unsigned ldsw = (unsigned)wid * 1024u;
    const int aoff = lds_byte(wr * (16 * MT) + fr, fq * 8), boff = lds_byte(wc * 32 + fr, fq * 8);
#define PG8_SA(b, h) (((b) * 2 + (h)) * HTB)
#define PG8_SB(b, h) ((4 + (b) * 2 + (h)) * HTB)
#define PG8_STAGE(bufoff, gbase, voff) do { _Pragma("unroll") for (int _i = 0; _i < 2; ++_i) \
        __builtin_amdgcn_global_load_lds((const unsigned*)((const char*)(gbase) + (voff)[_i]), (PG8_LAS unsigned*)(lds + (bufoff) + ldsw + _i * 8192), 16, 0, 0); } while (0)
#define PG8_LDA(dst, b, h) do { _Pragma("unroll") for (int m = 0; m < MT; ++m) _Pragma("unroll") for (int k = 0; k < 2; ++k) dst[m][k] = *(const PG8_LAS bf16x8*)(lds + PG8_SA(b, h) + aoff + m * 2048 + k * 1024); } while (0)
#define PG8_LDB(dst, b, h) do { _Pragma("unroll") for (int n = 0; n < 2; ++n) _Pragma("unroll") for (int k = 0; k < 2; ++k) dst[n][k] = *(const PG8_LAS bf16x8*)(lds + PG8_SB(b, h) + boff + n * 2048 + k * 1024); } while (0)
#define PG8_MMA(ai, bj, At, Bt) do { __builtin_amdgcn_s_setprio(1); _Pragma("unroll") for (int m = 0; m < MT; ++m) _Pragma("unroll") for (int n = 0; n < 2; ++n) _Pragma("unroll") for (int k = 0; k < 2; ++k) \
        acc[ai][bj][m][n] = __builtin_amdgcn_mfma_f32_16x16x32_bf16(Bt[n][k], At[m][k], acc[ai][bj][m][n], 0, 0, 0); __builtin_amdgcn_s_setprio(0); } while (0)
#define PG8_WAIT_V(n) asm volatile("s_waitcnt vmcnt(" #n ")" ::: "memory")
#define PG8_WAIT_L(n) asm volatile("s_waitcnt lgkmcnt(" #n ")" ::: "memory")
#define PG8_BAR __builtin_amdgcn_s_barrier()
#define PG8_SCHED __builtin_amdgcn_sched_barrier(0)
    Unit cur, nxt; int ui = 0;
    if (!S.next(0, cur)) return;
    f32x4 acc[2][2][MT][2];
#pragma unroll
    for (int a = 0; a < 2; ++a)
#pragma unroll
        for (int b = 0; b < 2; ++b)
#pragma unroll
            for (int m = 0; m < MT; ++m)
#pragma unroll
                for (int n = 0; n < 2; ++n) acc[a][b][m][n] = (f32x4){0.f, 0.f, 0.f, 0.f};
    bf16x8 At[MT][2], B0[2][2], B1[2][2];
    const char* cA = (const char*)g.A + (size_t)cur.pm * tstepA; const char* cB = (const char*)g.Bt + (size_t)cur.pn * tstepB;
    S.a_ready(cur);
    if constexpr (SP2) {
        PG8_STAGE(PG8_SB(0, 0), cB, voffB); PG8_STAGE(PG8_SB(0, 1), cB + hstepB, voffB); PG8_STAGE(PG8_SA(0, 0), cA, voffA); PG8_STAGE(PG8_SA(0, 1), cA + hstepA, voffA);
        if (wr == 1) PG8_BAR;
        PG8_WAIT_V(2); PG8_BAR;
        PG8_STAGE(PG8_SB(1, 0), cB + kstepB, voffB); PG8_STAGE(PG8_SA(1, 0), cA + kstepA, voffA); PG8_STAGE(PG8_SB(1, 1), cB + hstepB + kstepB, voffB);
        PG8_WAIT_V(6); PG8_BAR;
    } else {
        PG8_STAGE(PG8_SB(0, 0), cB, voffB); PG8_STAGE(PG8_SA(0, 0), cA, voffA); PG8_STAGE(PG8_SB(0, 1), cB + hstepB, voffB); PG8_STAGE(PG8_SA(0, 1), cA + hstepA, voffA);
        if (wr == 1) PG8_BAR;
        PG8_WAIT_V(4); PG8_BAR;
        PG8_STAGE(PG8_SB(1, 0), cB + kstepB, voffB); PG8_STAGE(PG8_SA(1, 0), cA + kstepA, voffA); PG8_STAGE(PG8_SB(1, 1), cB + hstepB + kstepB, voffB);
        PG8_WAIT_V(6); PG8_BAR;
    }
    for (;;) {
        const bool has_next = S.next(ui + 1, nxt);
        const char* nA = has_next ? (const char*)g.A + (size_t)nxt.pm * tstepA : cA; const char* nB = has_next ? (const char*)g.Bt + (size_t)nxt.pn * tstepB : cB;
        for (int t = 0; t < nt; t += 2) {
            const bool last = (t == nt - 2);
            const char* a1 = cA + (size_t)(t + 1) * kstepA;
            const char* a2 = last ? nA : cA + (size_t)(t + 2) * kstepA; const char* b2 = last ? nB : cB + (size_t)(t + 2) * kstepB;
            const char* a3 = a2 + kstepA; const char* b3 = b2 + kstepB;
            if (last && has_next) S.a_ready(nxt);
            if constexpr (SP2) {
            PG8_LDB(B0, 0, 0); PG8_LDB(B1, 0, 1); PG8_SCHED; PG8_LDA(At, 0, 0); PG8_STAGE(PG8_SA(1, 1), a1 + hstepA, voffA);
            PG8_WAIT_V(8); PG8_WAIT_L(0); PG8_BAR; PG8_MMA(0, 0, At, B0); PG8_MMA(0, 1, At, B1); PG8_BAR; PG8_SCHED;
            PG8_LDA(At, 0, 1); PG8_STAGE(PG8_SB(0, 0), b2, voffB); PG8_STAGE(PG8_SB(0, 1), b2 + hstepB, voffB); PG8_STAGE(PG8_SA(0, 0), a2, voffA);
            PG8_WAIT_V(8); PG8_WAIT_L(0); PG8_BAR; PG8_MMA(1, 0, At, B0); PG8_MMA(1, 1, At, B1); PG8_BAR; PG8_SCHED;
            PG8_LDB(B0, 1, 0); PG8_LDB(B1, 1, 1); PG8_SCHED; PG8_LDA(At, 1, 0); PG8_STAGE(PG8_SA(0, 1), a2 + hstepA, voffA);
            PG8_WAIT_V(8); PG8_WAIT_L(0); PG8_BAR; PG8_MMA(0, 0, At, B0); PG8_MMA(0, 1, At, B1); PG8_BAR; PG8_SCHED;
            PG8_LDA(At, 1, 1); PG8_STAGE(PG8_SB(1, 0), b3, voffB); PG8_STAGE(PG8_SB(1, 1), b3 + hstepB, voffB); PG8_STAGE(PG8_SA(1, 0), a3, voffA);
            PG8_WAIT_V(8); PG8_WAIT_L(0); PG8_BAR; PG8_MMA(1, 0, At, B0); PG8_MMA(1, 1, At, B1); PG8_BAR; PG8_SCHED;
            } else {
            PG8_LDB(B0, 0, 0); PG8_SCHED; PG8_LDA(At, 0, 0); PG8_STAGE(PG8_SA(1, 1), a1 + hstepA, voffA);
            PG8_WAIT_L(8); PG8_BAR; PG8_WAIT_L(0); PG8_MMA(0, 0, At, B0); PG8_BAR; PG8_SCHED;
            PG8_LDB(B1, 0, 1); PG8_STAGE(PG8_SB(0, 0), b2, voffB);
            PG8_BAR; PG8_WAIT_L(0); PG8_MMA(0, 1, At, B1); PG8_BAR;
            PG8_LDA(At, 0, 1); PG8_STAGE(PG8_SA(0, 0), a2, voffA);
            PG8_BAR; PG8_WAIT_L(0); PG8_MMA(1, 0, At, B0); PG8_BAR; PG8_SCHED;
            PG8_STAGE(PG8_SB(0, 1), b2 + hstepB, voffB);
            PG8_WAIT_V(6); PG8_BAR; PG8_MMA(1, 1, At, B1); PG8_BAR;
            PG8_LDB(B0, 1, 0); PG8_SCHED; PG8_LDA(At, 1, 0); PG8_STAGE(PG8_SA(0, 1), a2 + hstepA, voffA);
            PG8_WAIT_L(8); PG8_BAR; PG8_WAIT_L(0); PG8_MMA(0, 0, At, B0); PG8_BAR; PG8_SCHED;
            PG8_LDB(B1, 1, 1); PG8_STAGE(PG8_SB(1, 0), b3, voffB);
            PG8_BAR; PG8_WAIT_L(0); PG8_MMA(0, 1, At, B1); PG8_BAR;
            PG8_LDA(At, 1, 1); PG8_STAGE(PG8_SA(1, 0), a3, voffA);
            PG8_BAR; PG8_WAIT_L(0); PG8_MMA(1, 0, At, B0); PG8_BAR; PG8_SCHED;
            PG8_STAGE(PG8_SB(1, 1), b3 + hstepB, voffB);
            PG8_WAIT_V(6); PG8_BAR; PG8_MMA(1, 1, At, B1); PG8_BAR;
            }
        }
        if constexpr (ALIGN_EPI) { if (wr == 0) PG8_BAR; }
        if constexpr (!Epi::AFTER_DRAIN) { E(acc, cur, wr, wc, fr, fq); S.done(cur); }
        if (!has_next) break;
#pragma unroll
        for (int a = 0; a < 2; ++a)
#pragma unroll
            for (int b = 0; b < 2; ++b)
#pragma unroll
                for (int m = 0; m < MT; ++m)
#pragma unroll
                    for (int n = 0; n < 2; ++n) acc[a][b][m][n] = (f32x4){0.f, 0.f, 0.f, 0.f};
        cur = nxt; cA = nA; cB = nB; ++ui;
        if constexpr (ALIGN_EPI) { if (wr == 1) PG8_BAR; }
    }
    PG8_WAIT_V(0);
    if constexpr (!ALIGN_EPI) { if (wr == 0) PG8_BAR; }
    PG8_BAR;
    if constexpr (Epi::AFTER_DRAIN) { E.fused(acc, cur, wr, wc, fr, fq, lds, wid, lane); S.done(cur); }
#undef PG8_SA
#undef PG8_SB
#undef PG8_STAGE
#undef PG8_LDA
#undef PG8_LDB
#undef PG8_MMA
#undef PG8_WAIT_V
#undef PG8_WAIT_L
#undef PG8_BAR
#undef PG8_SCHED
}
}

constexpr int NWAVES = 8;
constexpr int M = 18432, MP = 16384, MS = 2048, D = 2048, FF = 5632, NH = 16, HD = 128, PLE = 256;
constexpr int SEQ = 4096, DSEQ = 64, DB = 32, NG = 128, NP = 64, CROWS = 512, SROWS = 576;
#ifndef MK_ONE_LAUNCH
#define MK_ONE_LAUNCH 1
#endif
constexpr int N_PHASES = 24;
#ifndef WD_BLOCKED
#define WD_BLOCKED 0
#endif
#ifndef ACT_BLOCKED
#define ACT_BLOCKED 1
#endif
#ifndef MT_DOWN
#define MT_DOWN 3
#endif
#ifndef WGM_UP
#define WGM_UP 8
#endif
#ifndef SP2_UP
#define SP2_UP true
#endif
#ifndef WGM_N2048
#define WGM_N2048 8
#endif
#ifndef ALIGN_RES
#define ALIGN_RES false
#endif
#ifndef MT_UP
#define MT_UP 4
#endif
#ifndef MT_N2048
#define MT_N2048 3
#endif
#ifndef MT_N4096
#define MT_N4096 4
#endif
constexpr size_t MiB = 1u << 20;
#ifndef KPAD
#define KPAD 64
#endif
constexpr int LDH = D + KPAD, LDACT = FF + KPAD, LDPB = PLE + KPAD;
constexpr size_t WS_CTL = 0, CTL_ZERO_BYTES = 1 * MiB;
constexpr size_t WS_SSQ = 256 * 1024;
constexpr size_t WS_WL = 2 * MiB, WL_STRIDE = 149 * MiB;
constexpr size_t WL_1GU = 0, WL_1D = 46 * MiB, WL_2GU = 69 * MiB, WL_2D = 115 * MiB, WL_PG = 138 * MiB, WL_PP = 147 * MiB;
constexpr size_t WS_WGLU = 300 * MiB, WS_WKV = 317 * MiB, WS_WQ = 334 * MiB, WS_WO = 343 * MiB;
constexpr size_t WS_HB = 352 * MiB;
constexpr size_t WS_ACT = 427 * MiB;
constexpr size_t WS_PROJ = 628 * MiB;
constexpr size_t WS_KP = 700 * MiB, WS_VP = 764 * MiB;
constexpr size_t WS_KS = 828 * MiB, WS_VS = 900 * MiB;
constexpr size_t WS_PB = 972 * MiB;
constexpr size_t WS_S5L = 1011 * MiB;
constexpr size_t WS_S5B = 1012 * MiB;
constexpr size_t WS_TAB = 1013 * MiB;
constexpr size_t WS_HB2 = 1014 * MiB;
constexpr size_t WS_END = 1089 * MiB;
static_assert((size_t)M * LDH * 2 <= 75 * MiB && (size_t)M * LDACT * 2 <= 201 * MiB && (size_t)2 * FF * LDH * 2 <= 46 * MiB && (size_t)D * LDACT * 2 <= 23 * MiB && (size_t)D * LDH * 2 <= 9 * MiB && (size_t)D * LDPB * 2 <= 2 * MiB && (size_t)2 * M * LDPB * 2 <= 23 * MiB && (size_t)2 * D * LDH * 2 <= 17 * MiB, "d_ws map");
constexpr int CW_BAR = 4096;
constexpr int RING_BYTES = 131072, XCH_OFF = 131072, XCH_BYTES = 8192, MISC_OFF = XCH_OFF + XCH_BYTES, LDS_BYTES = 147456;

#define GAS __attribute__((address_space(1)))
#define LAS __attribute__((address_space(3)))
typedef unsigned short bf16;
typedef unsigned v4u __attribute__((ext_vector_type(4)));
typedef unsigned v2u __attribute__((ext_vector_type(2)));
typedef float f32x4 __attribute__((ext_vector_type(4)));
typedef float f32x16 __attribute__((ext_vector_type(16)));
typedef short bf16x8 __attribute__((ext_vector_type(8)));
typedef short s16x4 __attribute__((ext_vector_type(4)));
typedef GAS unsigned gu32;
#define RLX_AGENT __ATOMIC_RELAXED, __HIP_MEMORY_SCOPE_AGENT
#define LDS_WAIT() asm volatile("s_waitcnt lgkmcnt(0)" ::: "memory")
#define VM_WAIT() asm volatile("s_waitcnt vmcnt(0)" ::: "memory")
__device__ __forceinline__ unsigned pk2(float lo, float hi) { return pg8::cvt_pk_bf16(lo, hi); }
__device__ __forceinline__ float bf2f(unsigned short b) { return __uint_as_float(((unsigned)b) << 16); }
#define XB_TMO      128
#define XB_XCNT(j)  (256  + 64 * (j))
#define XB_XSUB(j)  (1280 + 64 * (j))
#define XB_XGEN(j)  (2304 + 64 * (j))
#define XB_TOP      3328
#define XB_TOPGEN   3392
#define XCD_BAR_WORDS 3456
#define XB_SPIN_CAP (1u << 18)

__device__ __forceinline__ unsigned xb_ld(unsigned* p)              { return __hip_atomic_load(p, __ATOMIC_RELAXED, __HIP_MEMORY_SCOPE_AGENT); }
__device__ __forceinline__ unsigned xb_add(unsigned* p, unsigned v) { return __hip_atomic_fetch_add(p, v, __ATOMIC_RELAXED, __HIP_MEMORY_SCOPE_AGENT); }
__device__ __forceinline__ unsigned xb_xcc_id() { return (unsigned)__builtin_amdgcn_s_getreg((3 << 11) | 20) & 0xFu; }
#define XB_SPIN(cond, bar) do { unsigned _sp = 0; while (cond) { __builtin_amdgcn_s_sleep(1); \
    if ((++_sp & 255u) == 0u) { if (xb_ld(&(bar)[XB_TMO])) break; if (_sp > XB_SPIN_CAP) { atomicAdd(&(bar)[XB_TMO], 1u); break; } } } } while (0)

struct XcdBarrier {
    unsigned* bar; unsigned x;
    volatile LAS unsigned* st;
};

__device__ __forceinline__ XcdBarrier xcd_barrier_post(unsigned* bar, volatile LAS unsigned* st) {
    XcdBarrier b; b.bar = bar; b.x = xb_xcc_id(); b.st = st;
    if (threadIdx.x == 0) (void)xb_add(&bar[XB_XCNT(b.x)], 1u);
    return b;
}
__device__ __forceinline__ void xcd_barrier_complete(unsigned* bar, unsigned x, unsigned& nloc, unsigned& nx) {
    const unsigned G = gridDim.x * gridDim.y * gridDim.z;
    unsigned sum, cnt, mine, sp = 0u;
    for (;;) {
        sum = 0u; cnt = 0u; mine = 0u;
#pragma unroll
        for (unsigned j = 0; j < 16; ++j) { const unsigned c = xb_ld(&bar[XB_XCNT(j)]); sum += c; cnt += (c > 0u) ? 1u : 0u; mine = (j == x) ? c : mine; }
        if (sum == G) break;
        __builtin_amdgcn_s_sleep(1);
        if ((++sp & 255u) == 0u) { if (xb_ld(&bar[XB_TMO])) break; if (sp > XB_SPIN_CAP) { atomicAdd(&bar[XB_TMO], 1u); break; } }
    }
    nloc = mine > 0u ? mine : 1u; nx = cnt > 0u ? cnt : 1u;
}

__device__ __forceinline__ void xcd_barrier(const XcdBarrier& b) {
    asm volatile("s_waitcnt vmcnt(0)" ::: "memory");
    __syncthreads();
    if (threadIdx.x == 0) {
        unsigned* bar = b.bar;
        __builtin_amdgcn_s_waitcnt(0);
        unsigned nloc = b.st[0], nx = b.st[1];
        if (nloc == 0u) { xcd_barrier_complete(bar, b.x, nloc, nx); b.st[0] = nloc; b.st[1] = nx; }
        const unsigned old = xb_add(&bar[XB_XSUB(b.x)], 1u);
        const unsigned gen = old / nloc;
        if (old + 1u == (gen + 1u) * nloc) {
            __builtin_amdgcn_fence(__ATOMIC_RELEASE, "agent");
            asm volatile("s_waitcnt vmcnt(0)" ::: "memory");
            const unsigned og = xb_add(&bar[XB_TOP], 1u);
            const unsigned tg = og / nx;
            if (og + 1u == (tg + 1u) * nx) xb_add(&bar[XB_TOPGEN], 1u);
            else XB_SPIN(xb_ld(&bar[XB_TOPGEN]) == tg, bar);
            __builtin_amdgcn_fence(__ATOMIC_ACQUIRE, "agent");
            xb_add(&bar[XB_XGEN(b.x)], 1u);
            asm volatile("s_waitcnt vmcnt(0)" ::: "memory");
        } else {
            XB_SPIN(xb_ld(&bar[XB_XGEN(b.x)]) == gen, bar);
            __builtin_amdgcn_fence(__ATOMIC_ACQUIRE, "agent");
            asm volatile("s_waitcnt vmcnt(0)" ::: "memory");
        }
    }
    __syncthreads();
}

struct Args { const float* in[38]; float* out; unsigned char* ws; int ph_lo, ph_hi; };
enum { I_XP = 0, I_XS, I_SRE, I_SIM, I_CK, I_CV, I_PP, I_PS, I_F1G, I_F1WG, I_F1WU, I_F1WD, I_F2G, I_F2WG, I_F2WU, I_F2WD, I_MIXG, I_LRE, I_LIM, I_LDT, I_BRE, I_BIM, I_CRE, I_CIM, I_SD, I_GLA, I_GLB,
       I_KVG, I_WK, I_WV, I_KNG, I_WQ, I_QNG, I_RB, I_WO, I_PLG, I_PLWG, I_PLWP };
constexpr size_t O_YP = 0, O_YS = 33554432, O_PSRE = 37748736, O_PSIM = O_PSRE + 32768, O_PK = O_PSIM + 32768, O_PV = O_PK + 4194304, O_SSRE = O_PV + 4194304, O_SSIM = O_SSRE + 262144,
                 O_SK = O_SSIM + 262144, O_SV = O_SK + 4194304, O_END = O_SV + 4194304;
static_assert(O_END == 55115776, "output size");

__device__ __forceinline__ float wave_sum(float v) {
#pragma unroll
    for (int o = 1; o < 64; o <<= 1) v += __shfl_xor(v, o);
    return v;
}
struct TrRegs { float v[32]; };
__device__ __forceinline__ void tr_load(TrRegs& r, const float* W, int N, const float* gain, int item, int lane) {
    const int nblk = N / 32, kb = item / nblk, nb = item % nblk, k0 = 64 * kb, n0 = 32 * nb;
    const float* p = W + (size_t)(k0 + (lane >> 5)) * N + n0 + (lane & 31);
#pragma unroll
    for (int i = 0; i < 32; ++i) r.v[i] = p[(size_t)(2 * i) * N];
    if (gain) {
#pragma unroll
        for (int i = 0; i < 32; ++i) r.v[i] *= gain[k0 + 2 * i + (lane >> 5)];
    }
}
__device__ __forceinline__ void tr_store(const TrRegs& r, int K, int N, bf16* WT, int ldk, int blk, int row_off, LAS float* scr, int item, int lane) {
    const int nblk = N / 32, kb = item / nblk, nb = item % nblk, k0 = 64 * kb, n0 = 32 * nb;
#pragma unroll
    for (int i = 0; i < 32; ++i) scr[(2 * i + (lane >> 5)) * 33 + (lane & 31)] = r.v[i];
    LDS_WAIT(); asm volatile("" ::: "memory");
    const int c = lane & 7;
#pragma unroll
    for (int j = 0; j < 4; ++j) { const int n = (lane >> 3) + 8 * j; const LAS float* s = scr + (8 * c) * 33 + n;
        v4u o; o.x = pk2(s[0 * 33], s[1 * 33]); o.y = pk2(s[2 * 33], s[3 * 33]); o.z = pk2(s[4 * 33], s[5 * 33]); o.w = pk2(s[6 * 33], s[7 * 33]);
        const int nn = n0 + n, drow = (nn >> 7) * blk + (nn & 127) + row_off;
        if (ldk) *(GAS v4u*)(WT + (size_t)drow * ldk + k0 + 8 * c) = o;
        else *(GAS v4u*)((char*)WT + (size_t)(drow >> 8) * ((size_t)(K / 64) * 32768) + (size_t)(k0 >> 6) * 32768 + (drow & 255) * 128 + 16 * c) = o; }
    LDS_WAIT(); asm volatile("" ::: "memory");
}
__device__ __forceinline__ void tr_matrix(const float* W, int K, int N, const float* gain, bf16* WT, int blk, int row_off, LAS float* scr, int gw, int NGW, int lane, int& base, bool blocked = false) {
    const int ldk = blocked ? 0 : K + KPAD;
    const int items = (K / 64) * (N / 32);
    int st = (gw - (base % NGW)); if (st < 0) st += NGW;
    base += items;
    if (st >= items) return;
    TrRegs cur, nxt;
    tr_load(cur, W, N, gain, st, lane);
    for (int it = st; it < items; it += NGW) {
        const bool more = it + NGW < items;
        if (more) tr_load(nxt, W, N, gain, it + NGW, lane);
        tr_store(cur, K, N, WT, ldk, blk, row_off, scr, it, lane);
        if (more) {
#pragma unroll
            for (int i = 0; i < 32; ++i) cur.v[i] = nxt.v[i];
        }
    }
}
__device__ __forceinline__ float row2048_to_bf16(const float* src, bf16* dst, int lane) {
    const GAS f32x4* xr = (const GAS f32x4*)src + lane; GAS v2u* o8 = (GAS v2u*)dst + lane; float s = 0.f;
    f32x4 v[8];
#pragma unroll
    for (int j = 0; j < 8; ++j) v[j] = xr[64 * j];
#pragma unroll
    for (int j = 0; j < 8; ++j) { s += (v[j][0] * v[j][0] + v[j][1] * v[j][1]) + (v[j][2] * v[j][2] + v[j][3] * v[j][3]); v2u w; w.x = pk2(v[j][0], v[j][1]); w.y = pk2(v[j][2], v[j][3]); o8[64 * j] = w; }
    return s;
}


__device__ __forceinline__ pg8::RangeOrder proj_tail(int G, int bx, int part) {
    constexpr int NN = D / 256, P = (M / (64 * MT_N2048)) * NN, NWG_UP = (M / (64 * MT_UP)) * (2 * FF / 256);
    pg8::RangeOrder S; S.nN = NN; S.first = 0; S.count = 0;
    const int rem = NWG_UP % G, ns = G - rem, a = 3 * ns, R = P - a, n2 = R - ns;
    if (rem == 0 || R < 0 || n2 < 0 || n2 > ns) { if (part == 0) { const int per = (P + G - 1) / G; S.first = bx * per; S.count = P - S.first < per ? P - S.first : per; if (S.count < 0) S.count = 0; } return S; }
    const int c = bx - rem;
    if (c < 0) return S;
    if (part == 0) { S.first = 3 * c; S.count = 3; }
    else { S.count = c < n2 ? 2 : 1; S.first = a + (c < n2 ? 2 * c : 2 * n2 + (c - n2)); }
    return S;
}

__device__ __forceinline__ float gelu_tanh(float x) {
    const float a = 0.7978845608028654f * (x + 0.044715f * x * x * x);
    return x * __builtin_amdgcn_rcpf(1.0f + __builtin_amdgcn_exp2f(-2.885390081777927f * a));
}
__device__ __forceinline__ void s5_stage_u(const float* h, const float* ssq, const float* gm, int row0, int g, LAS float* ut, int lane) {
    const int row = row0 + lane;
    const float rs = rsqrtf(ssq[row] * (1.0f / 2048.0f) + 1e-6f);
    const f32x4* hp = (const f32x4*)(h + (size_t)row * D + 16 * g); const f32x4* gp = (const f32x4*)(gm + 16 * g);
#pragma unroll
    for (int k = 0; k < 4; ++k) { const f32x4 v = hp[k] * rs * gp[k]; *(LAS f32x4*)(ut + lane * 16 + 4 * k) = v; }
    LDS_WAIT(); asm volatile("" ::: "memory");
}

__device__ __forceinline__ void s5_prefix(const f32x4* lamtab, float2* E, int gw, int NGW, int lane) {
    float2* HIN = E + (size_t)4 * 64 * NG * NP;
    for (int it = gw; it < 4 * NG; it += NGW) {
        const int g = it & 127, b = it >> 7;
        const f32x4 lam = lamtab[g * 64 + lane];
        const size_t base = ((size_t)b * 64 * 128 + g) * 64 + lane;
        float2 e[63];
#pragma unroll
        for (int c = 0; c < 63; ++c) e[c] = E[base + (size_t)c * 128 * 64];
        float hr = 0.f, hi = 0.f;
        HIN[base] = make_float2(0.f, 0.f);
#pragma unroll
        for (int c = 0; c < 63; ++c) { const float t = lam[2] * hr - lam[3] * hi + e[c].x; hi = lam[2] * hi + lam[3] * hr + e[c].y; hr = t; HIN[base + (size_t)(c + 1) * 128 * 64] = make_float2(hr, hi); }
    }
}
constexpr int S5_HS = 16 * 272;
constexpr int S5_WAVE_LDS = 2 * S5_HS + 2048 + 1024;
template <bool WITH_Y>
__device__ __forceinline__ void s5_mfma(const bf16* h, const float* ssq, const float* gm, const f32x4* lamtab, const float* bbar, const float* cre_g, const float* cim_g, const float* dsk, float2* E,
                                        const float* sre, const float* sim, bf16* zb, float* o_pre, float* o_pim, float* o_sre, float* o_sim, LAS char* wl, int gw, int NGW, int lane, bool emode) {
    const int col = lane & 31, hh = lane >> 5;
    const int NIT = (WITH_Y && !emode) ? (2 * 64 * NG + 16 * NG) : (2 * 64 * NG);
    LAS float* ut = (LAS float*)(wl + 2 * S5_HS); LAS unsigned short* zt = (LAS unsigned short*)(wl + 2 * S5_HS + 2048);
    for (int it = gw; it < NIT; it += NGW) {
        const bool samp = it >= 2 * 64 * NG;
        int g, c, b0;
        if (!samp) { g = it & 127; c = (it >> 7) & 63; b0 = 2 * (it >> 13); } else { const int i2 = it - 2 * 64 * NG; g = i2 & 127; c = 0; b0 = 2 * (i2 >> 7); }
        const int rowbase0 = samp ? MP + b0 * DSEQ : b0 * SEQ + c * 64;
        const int seqstride = samp ? DSEQ : SEQ;
        f32x4 lamA = lamtab[g * 64 + col], lamB = lamtab[g * 64 + col + 32];
        bf16x8 bhi[4], blo[4];
#pragma unroll
        for (int cb = 0; cb < 4; ++cb) { const float* bp = bbar + (size_t)(g * 64 + col + 32 * (cb & 1)) * 32 + 16 * (cb >> 1) + 8 * hh;
            const f32x4 x0 = *(const f32x4*)bp, x1 = *(const f32x4*)(bp + 4); float xv[8] = {x0[0], x0[1], x0[2], x0[3], x1[0], x1[1], x1[2], x1[3]}; unsigned hw[4], lw[4];
#pragma unroll
            for (int j = 0; j < 4; ++j) { const unsigned hp = pk2(xv[2 * j], xv[2 * j + 1]); hw[j] = hp; lw[j] = pk2(xv[2 * j] - __uint_as_float(hp << 16), xv[2 * j + 1] - __uint_as_float(hp & 0xffff0000u)); }
            v4u a; a.x = hw[0]; a.y = hw[1]; a.z = hw[2]; a.w = hw[3]; bhi[cb] = __builtin_bit_cast(bf16x8, a); a.x = lw[0]; a.y = lw[1]; a.z = lw[2]; a.w = lw[3]; blo[cb] = __builtin_bit_cast(bf16x8, a); }
        const f32x4 gm0 = *(const f32x4*)(gm + 16 * g + 8 * hh), gm1 = *(const f32x4*)(gm + 16 * g + 8 * hh + 4);
        bf16x8 cf[4]; float dch = 0.f;
        if (WITH_Y) {
            const int cc = lane & 15, kg = lane >> 4;
#pragma unroll
            for (int s = 0; s < 4; ++s) { const int p0 = 8 * s + 2 * kg;
                const float* cr = cre_g + (size_t)(g * 16 + cc) * 64 + p0; const float* ci = cim_g + (size_t)(g * 16 + cc) * 64 + p0;
                v4u a; a.x = pk2(cr[0], -ci[0]); a.y = pk2(cr[32], -ci[32]); a.z = pk2(cr[1], -ci[1]); a.w = pk2(cr[33], -ci[33]); cf[s] = __builtin_bit_cast(bf16x8, a); }
            dch = dsk[16 * g + cc];
        }
        float hAr = 0.f, hAi = 0.f, hBr = 0.f, hBi = 0.f;
        if (WITH_Y && !emode) {
            if (!samp) { { const float2* hin = E + (size_t)4 * 64 * NG * NP + (((size_t)(b0 + hh) * 64 + c) * 128 + g) * 64;
                    const float2 ea = hin[col], ec = hin[col + 32]; hAr = ea.x; hAi = ea.y; hBr = ec.x; hBi = ec.y; } }
            else { const size_t sb = (size_t)((b0 + hh) * NG + g) * 64; hAr = sre[sb + col]; hAi = sim[sb + col]; hBr = sre[sb + col + 32]; hBi = sim[sb + col + 32]; }
        }
        const int aseq = (col >> 2) & 1, atok = (col & 3) + 4 * (col >> 3);
        {
        const int rb0 = rowbase0; const bool doy = WITH_Y && !emode;
        for (int blk = 0; blk < 4; ++blk) {
            const int arow = rb0 + aseq * seqstride + 16 * blk + atok;
            const float rs = rsqrtf(ssq[arow] * (1.0f / 2048.0f) + 1e-6f);
            const v4u hraw = *(const GAS v4u*)(h + (size_t)arow * LDH + 16 * g + 8 * hh);
            f32x4 h0, h1; h0[0] = __uint_as_float(hraw.x << 16); h0[1] = __uint_as_float(hraw.x & 0xffff0000u); h0[2] = __uint_as_float(hraw.y << 16); h0[3] = __uint_as_float(hraw.y & 0xffff0000u);
            h1[0] = __uint_as_float(hraw.z << 16); h1[1] = __uint_as_float(hraw.z & 0xffff0000u); h1[2] = __uint_as_float(hraw.w << 16); h1[3] = __uint_as_float(hraw.w & 0xffff0000u);
            const f32x4 u0 = h0 * rs * gm0, u1 = h1 * rs * gm1;
            bf16x8 ahi, alo;
            { float xv[8] = {u0[0], u0[1], u0[2], u0[3], u1[0], u1[1], u1[2], u1[3]}; unsigned hw[4], lw[4];
#pragma unroll
              for (int j = 0; j < 4; ++j) { const unsigned hp = pk2(xv[2 * j], xv[2 * j + 1]); hw[j] = hp; lw[j] = pk2(xv[2 * j] - __uint_as_float(hp << 16), xv[2 * j + 1] - __uint_as_float(hp & 0xffff0000u)); }
              v4u a; a.x = hw[0]; a.y = hw[1]; a.z = hw[2]; a.w = hw[3]; ahi = __builtin_bit_cast(bf16x8, a); a.x = lw[0]; a.y = lw[1]; a.z = lw[2]; a.w = lw[3]; alo = __builtin_bit_cast(bf16x8, a); }
            if (WITH_Y && doy) { LAS f32x4* up = (LAS f32x4*)(ut + (aseq * 16 + atok) * 16 + 8 * hh); up[0] = u0; up[1] = u1; }
            f32x16 bu[4];
#pragma unroll
            for (int cb = 0; cb < 4; ++cb) {
#pragma unroll
                for (int i = 0; i < 16; ++i) bu[cb][i] = 0.f;
                bu[cb] = __builtin_amdgcn_mfma_f32_32x32x16_bf16(alo, bhi[cb], bu[cb], 0, 0, 0);
                bu[cb] = __builtin_amdgcn_mfma_f32_32x32x16_bf16(ahi, blo[cb], bu[cb], 0, 0, 0);
                bu[cb] = __builtin_amdgcn_mfma_f32_32x32x16_bf16(ahi, bhi[cb], bu[cb], 0, 0, 0);
            }
#pragma unroll
            for (int i = 0; i < 16; ++i) {
                float t = lamA[0] * hAr - lamA[1] * hAi + bu[0][i]; hAi = lamA[0] * hAi + lamA[1] * hAr + bu[2][i]; hAr = t;
                t = lamB[0] * hBr - lamB[1] * hBi + bu[1][i]; hBi = lamB[0] * hBi + lamB[1] * hBr + bu[3][i]; hBr = t;
                if (WITH_Y && doy) { v2u w; w.x = pk2(hAr, hAi); w.y = pk2(hBr, hBi); *(LAS s16x4*)(wl + hh * S5_HS + i * 272 + col * 8) = __builtin_bit_cast(s16x4, w); }
            }
            if (WITH_Y && doy) {
                asm volatile("" ::: "memory");
                const int cc = lane & 15, kg = lane >> 4;
#pragma unroll
                for (int sq = 0; sq < 2; ++sq) {
                    f32x4 y = {0.f, 0.f, 0.f, 0.f};
#pragma unroll
                    for (int s = 0; s < 4; ++s) { const bf16x8 af = *(const LAS bf16x8*)(wl + sq * S5_HS + cc * 272 + 64 * s + 16 * kg);
                        y = __builtin_amdgcn_mfma_f32_16x16x32_bf16(af, cf[s], y, 0, 0, 0); }
#pragma unroll
                    for (int r = 0; r < 4; ++r) { const float uu = ut[(sq * 16 + 4 * kg + r) * 16 + cc]; const float z = gelu_tanh(y[r] + dch * uu);
                        zt[(sq * 16 + 4 * kg + r) * 16 + cc] = (unsigned short)(pk2(z, 0.f) & 0xffffu); }
                }
                asm volatile("" ::: "memory");
                if (lane < 32) { const int sq = lane >> 4, tok = lane & 15;
                    const bf16x8 z0 = *(const LAS bf16x8*)(zt + lane * 16), z1 = *(const LAS bf16x8*)(zt + lane * 16 + 8);
                    GAS bf16x8* zp = (GAS bf16x8*)(zb + (size_t)(rb0 + sq * seqstride + 16 * blk + tok) * LDH + 16 * g); zp[0] = z0; zp[1] = z1; }
            }
            asm volatile("" ::: "memory");
        }
        }
        if (!WITH_Y || emode) { const size_t eb = (((size_t)(b0 + hh) * 64 + c) * 128 + g) * 64; E[eb + col] = make_float2(hAr, hAi); E[eb + col + 32] = make_float2(hBr, hBi); }
        else if (samp || c == 63) { float* ore = samp ? o_sre : o_pre; float* oim = samp ? o_sim : o_pim; const size_t sb = (size_t)((b0 + hh) * NG + g) * 64;
            ore[sb + col] = hAr; oim[sb + col] = hAi; ore[sb + col + 32] = hBr; oim[sb + col + 32] = hBi; }
    }
}

namespace att {
typedef short v4i16_t __attribute__((ext_vector_type(4)));
constexpr int KBUF = 16384;
constexpr int K_OFF = 0, V_OFF = 2 * KBUF, TAB_OFF = 4 * KBUF, Q_OFF = TAB_OFF + 2560, ATT_LDS = Q_OFF + 8 * 8192;
__device__ __forceinline__ unsigned off_b(unsigned row, unsigned ch) { return 256u * row + 16u * (ch ^ (((row & 3) << 2) | ((row >> 2) & 3))); }
__device__ __forceinline__ s16x4 vtr(const LAS char* p) { return __builtin_bit_cast(s16x4, __builtin_amdgcn_ds_read_tr16_b64_v4i16((LAS v4i16_t*)p)); }
__device__ __forceinline__ int crow(int r, int hi) { return (r & 3) + 8 * (r >> 2) + 4 * hi; }
__device__ __forceinline__ void attn_unit(LAS char* lds, const bf16* Q, size_t qrow0, const bf16* Kseq, const bf16* Vseq, int hh, int cq0, int nqc, const float* tabg, bf16* O, int tid) {
    const int lane = tid & 63, w = __builtin_amdgcn_readfirstlane(tid >> 6), r = lane & 31, h = lane >> 5;
    const int wq = w >> 1; const bool active = wq < nqc; const int cq = cq0 + (active ? wq : 0);
    LAS float* tab = (LAS float*)(lds + TAB_OFF);
    for (int i = tid; i < 640; i += 512) tab[i] = tabg[i];
    const size_t qrow = qrow0 + (size_t)(active ? wq : 0) * 64 + (w & 1) * 32 + r;
    LAS char* qpark = lds + Q_OFF + w * 8192 + lane * 16;
#pragma unroll
    for (int s = 0; s < 8; ++s) *(LAS bf16x8*)(qpark + 1024 * s) = *(const bf16x8*)(Q + qrow * LDH + hh * HD + 16 * s + 8 * h);
    const int kc_lo = (cq0 - 8 > 0) ? cq0 - 8 : 0, kc_hi = cq0 + nqc - 1;
    const int srow0 = tid >> 4, sch = tid & 15;
    v4u kreg[2], vreg[2];
#define ATT_GLOAD(kc) do { _Pragma("unroll") for (int i = 0; i < 2; ++i) { const size_t go = ((size_t)(kc) * 64 + srow0 + 32 * i) * D + hh * HD + sch * 8; kreg[i] = *(const GAS v4u*)(Kseq + go); vreg[i] = *(const GAS v4u*)(Vseq + go); } } while (0)
#define ATT_LSTORE(buf) do { _Pragma("unroll") for (int i = 0; i < 2; ++i) { const unsigned o = off_b(srow0 + 32 * i, sch); *(LAS v4u*)(lds + K_OFF + (buf) * KBUF + o) = kreg[i]; *(LAS v4u*)(lds + V_OFF + (buf) * KBUF + o) = vreg[i]; } } while (0)
    ATT_GLOAD(kc_lo); ATT_LSTORE(0);
    __syncthreads();
    f32x16 o[4];
#pragma unroll
    for (int c = 0; c < 4; ++c)
#pragma unroll
        for (int i = 0; i < 16; ++i) o[c][i] = 0.f;
    float mrun = -1e30f, lsum = 0.f;
    const int tq = 32 * (w & 1) + r;
    const int q4 = (lane & 15) >> 2, p4 = lane & 3, blk16 = (lane >> 4) & 1;
    for (int kc = kc_lo; kc <= kc_hi; ++kc) {
        const int cur = (kc - kc_lo) & 1;
        if (kc < kc_hi) ATT_GLOAD(kc + 1);
        if (active && kc >= cq - 8 && kc <= cq) {
            const int jrel = kc - (cq - 8);
            const LAS char* Kb = lds + K_OFF + cur * KBUF; const LAS char* Vb = lds + V_OFF + cur * KBUF;
            f32x16 p0, p1;
#pragma unroll
            for (int i = 0; i < 16; ++i) { p0[i] = 0.f; p1[i] = 0.f; }
#pragma unroll
            for (int s = 0; s < 8; ++s) {
                const bf16x8 k0 = *(const LAS bf16x8*)(Kb + off_b(r, 2 * s + h)), k1 = *(const LAS bf16x8*)(Kb + off_b(32 + r, 2 * s + h));
                const bf16x8 qs = *(const LAS bf16x8*)(qpark + 1024 * s);
                p0 = __builtin_amdgcn_mfma_f32_32x32x16_bf16(k0, qs, p0, 0, 0, 0); p1 = __builtin_amdgcn_mfma_f32_32x32x16_bf16(k1, qs, p1, 0, 0, 0);
                if ((s & 1) == 1) __builtin_amdgcn_sched_barrier(0);
            }
            const LAS float* tb = tab + (64 * jrel + 63 - tq + 4 * h);
            float mx = -1e30f;
#pragma unroll
            for (int i = 0; i < 16; ++i) { const int kr = (i & 3) + 8 * (i >> 2); p0[i] += tb[kr]; p1[i] += tb[kr + 32]; mx = fmaxf(mx, fmaxf(p0[i], p1[i])); }
            __builtin_amdgcn_sched_barrier(0);
            mx = fmaxf(mx, __shfl_xor(mx, 32));
            const float mnew = fmaxf(mrun, mx), alpha = __builtin_amdgcn_exp2f(mrun - mnew); mrun = mnew;
            float ps = 0.f;
#pragma unroll
            for (int i = 0; i < 16; ++i) { p0[i] = __builtin_amdgcn_exp2f(p0[i] - mnew); p1[i] = __builtin_amdgcn_exp2f(p1[i] - mnew); ps += p0[i] + p1[i]; }
            lsum = lsum * alpha + ps;
#pragma unroll
            for (int c = 0; c < 4; ++c)
#pragma unroll
                for (int i = 0; i < 16; ++i) o[c][i] *= alpha;
#pragma unroll
            for (int blk = 0; blk < 2; ++blk)
#pragma unroll
                for (int s2 = 0; s2 < 2; ++s2) {
                    const f32x16& pp = blk ? p1 : p0;
                    v4u pw; pw.x = pk2(pp[8 * s2], pp[8 * s2 + 1]); pw.y = pk2(pp[8 * s2 + 2], pp[8 * s2 + 3]); pw.z = pk2(pp[8 * s2 + 4], pp[8 * s2 + 5]); pw.w = pk2(pp[8 * s2 + 6], pp[8 * s2 + 7]);
                    const bf16x8 pf = __builtin_bit_cast(bf16x8, pw);
                    const int R0 = 32 * blk + 16 * s2 + 4 * h + q4;
#pragma unroll
                    for (int c = 0; c < 4; ++c) {
                        const unsigned ch = 4 * c + 2 * blk16 + (p4 >> 1);
                        const s16x4 lo = vtr(Vb + off_b(R0, ch) + 8 * (p4 & 1)), hi = vtr(Vb + off_b(R0 + 8, ch) + 8 * (p4 & 1));
                        const bf16x8 vf = __builtin_shufflevector(lo, hi, 0, 1, 2, 3, 4, 5, 6, 7);
                        o[c] = __builtin_amdgcn_mfma_f32_32x32x16_bf16(vf, pf, o[c], 0, 0, 0);
                    }
                    __builtin_amdgcn_sched_barrier(0);
                }
        }
        if (kc < kc_hi) ATT_LSTORE(cur ^ 1);
        __syncthreads();
    }
#undef ATT_GLOAD
#undef ATT_LSTORE
    if (active) {
        const float lt = lsum + __shfl_xor(lsum, 32), inv = 1.0f / lt;
        bf16* op = O + qrow * LDH + hh * HD + 4 * h;
#pragma unroll
        for (int c = 0; c < 4; ++c)
#pragma unroll
            for (int g4 = 0; g4 < 4; ++g4) { v2u wv; wv.x = pk2(o[c][4 * g4] * inv, o[c][4 * g4 + 1] * inv); wv.y = pk2(o[c][4 * g4 + 2] * inv, o[c][4 * g4 + 3] * inv); *(GAS v2u*)(op + 32 * c + 8 * g4) = wv; }
    }
}
static_assert(ATT_LDS <= 139264, "attention LDS");
}

__global__ void __launch_bounds__(NWAVES * 64, 2) mega_fwd(Args args) {
    extern __shared__ __attribute__((aligned(16))) unsigned char lds_raw[];
    LAS unsigned char* lds = (LAS unsigned char*)lds_raw;
    volatile LAS unsigned* MISC = (volatile LAS unsigned*)(lds + MISC_OFF);
    const int tid = threadIdx.x, lane = tid & 63, wave = __builtin_amdgcn_readfirstlane(tid >> 6);
    const int G = gridDim.x, bx = blockIdx.x, vcu = (G % 8 == 0) ? (bx % 8) * (G / 8) + bx / 8 : bx;
    const int gw = vcu * NWAVES + wave, NGW = G * NWAVES;
    unsigned char* ws = args.ws;
    gu32* ctl = (gu32*)(ws + WS_CTL);
    float* ssq = (float*)(ws + WS_SSQ);
    bf16* HB = (bf16*)(ws + WS_HB); bf16* HB2 = (bf16*)(ws + WS_HB2); bf16* ACT = (bf16*)(ws + WS_ACT); bf16* ZQO = (bf16*)(ws + WS_ACT); bf16* PROJ = (bf16*)(ws + WS_PROJ);
    bf16* KP = (bf16*)(ws + WS_KP); bf16* VP = (bf16*)(ws + WS_VP); bf16* KS = (bf16*)(ws + WS_KS); bf16* VS = (bf16*)(ws + WS_VS);
    bf16* PB = (bf16*)(ws + WS_PB); float2* EST = (float2*)(ws + WS_KP);   f32x4* S5L = (f32x4*)(ws + WS_S5L); float* S5B = (float*)(ws + WS_S5B); float* TAB = (float*)(ws + WS_TAB);
    float* Hres = args.out;
    for (int u = tid; u < (LDS_BYTES - MISC_OFF) / 4; u += NWAVES * 64) ((LAS unsigned*)(lds + MISC_OFF))[u] = 0u;
    __syncthreads();
#if MK_ONE_LAUNCH
    XcdBarrier bar = xcd_barrier_post((unsigned*)(ctl + CW_BAR), MISC + 8);
#define GRID_BAR() xcd_barrier(bar)
#else
#define GRID_BAR() do {} while (0)
#endif
    const int lo = args.ph_lo, hi = args.ph_hi;
#define IN(k) (lo <= (k) && (k) < hi)
#define SEAM() GRID_BAR()

    if (IN(0)) {
        LAS float* scr = (LAS float*)(lds + wave * 16384);
        int base = 0;
#pragma unroll
        for (int l = 0; l < 2; ++l) {
            unsigned char* wl = ws + WS_WL + l * WL_STRIDE;
            tr_matrix(args.in[I_F1WG] + (size_t)l * D * FF, D, FF, args.in[I_F1G] + l * D, (bf16*)(wl + WL_1GU), 256, 0, scr, gw, NGW, lane, base);
            tr_matrix(args.in[I_F1WU] + (size_t)l * D * FF, D, FF, args.in[I_F1G] + l * D, (bf16*)(wl + WL_1GU), 256, 128, scr, gw, NGW, lane, base);
            tr_matrix(args.in[I_F1WD] + (size_t)l * D * FF, FF, D, nullptr, (bf16*)(wl + WL_1D), 128, 0, scr, gw, NGW, lane, base, WD_BLOCKED);
            tr_matrix(args.in[I_F2WG] + (size_t)l * D * FF, D, FF, args.in[I_F2G] + l * D, (bf16*)(wl + WL_2GU), 256, 0, scr, gw, NGW, lane, base);
            tr_matrix(args.in[I_F2WU] + (size_t)l * D * FF, D, FF, args.in[I_F2G] + l * D, (bf16*)(wl + WL_2GU), 256, 128, scr, gw, NGW, lane, base);
            tr_matrix(args.in[I_F2WD] + (size_t)l * D * FF, FF, D, nullptr, (bf16*)(wl + WL_2D), 128, 0, scr, gw, NGW, lane, base, WD_BLOCKED);
            tr_matrix(args.in[I_PLWG] + (size_t)l * D * D, D, D, args.in[I_PLG] + l * D, (bf16*)(wl + WL_PG), 128, 0, scr, gw, NGW, lane, base);
            tr_matrix(args.in[I_PLWP] + (size_t)l * PLE * D, PLE, D, nullptr, (bf16*)(wl + WL_PP), 128, 0, scr, gw, NGW, lane, base);
        }
        tr_matrix(args.in[I_GLA], D, D, nullptr, (bf16*)(ws + WS_WGLU), 256, 0, scr, gw, NGW, lane, base);
        tr_matrix(args.in[I_GLB], D, D, nullptr, (bf16*)(ws + WS_WGLU), 256, 128, scr, gw, NGW, lane, base);
        tr_matrix(args.in[I_WK], D, D, args.in[I_KVG], (bf16*)(ws + WS_WKV), 128, 0, scr, gw, NGW, lane, base);
        tr_matrix(args.in[I_WV], D, D, args.in[I_KVG], (bf16*)(ws + WS_WKV), 128, 2048, scr, gw, NGW, lane, base);
        tr_matrix(args.in[I_WQ], D, D, args.in[I_MIXG] + D, (bf16*)(ws + WS_WQ), 128, 0, scr, gw, NGW, lane, base);
        tr_matrix(args.in[I_WO], D, D, nullptr, (bf16*)(ws + WS_WO), 128, 0, scr, gw, NGW, lane, base);
        for (int m = gw; m < M; m += NGW) { const float* src = (m < MP) ? args.in[I_XP] + (size_t)m * D : args.in[I_XS] + (size_t)(m - MP) * D;
            const float s = wave_sum(row2048_to_bf16(src, HB + (size_t)m * LDH, lane)); if (lane == 0) ssq[m] = s; }
        for (int m = gw; m < DB * CROWS; m += NGW) { const int b = m >> 9, t = m & 511;
            (void)row2048_to_bf16(args.in[I_CK] + (size_t)m * D, KS + (size_t)(b * SROWS + t) * D, lane);
            (void)row2048_to_bf16(args.in[I_CV] + (size_t)m * D, VS + (size_t)(b * SROWS + t) * D, lane); }
        for (int m = gw; m < 2 * M; m += NGW) { const int l = m / M, r = m % M;
            const float* src = (r < MP) ? args.in[I_PP] + ((size_t)l * MP + r) * PLE : args.in[I_PS] + ((size_t)l * MS + (r - MP)) * PLE;
            const f32x4 v = ((const GAS f32x4*)src)[lane]; v2u w; w.x = pk2(v[0], v[1]); w.y = pk2(v[2], v[3]); ((GAS v2u*)(PB + (size_t)m * LDPB))[lane] = w; }
        { const int i = gw * 64 + lane;
          if (i < NG * NP) { const int g = i >> 6;
            const double lre = args.in[I_LRE][i], lim = args.in[I_LIM][i], dt = exp((double)args.in[I_LDT][g]);
            const double er = exp(lre * dt), sn = sin(lim * dt), cs = cos(lim * dt), lbr = er * cs, lbi = er * sn;
            const double e128 = exp(lre * dt * 64.0), s128 = sin(lim * dt * 64.0), c128 = cos(lim * dt * 64.0);
            f32x4 lv; lv[0] = (float)lbr; lv[1] = (float)lbi; lv[2] = (float)(e128 * c128); lv[3] = (float)(e128 * s128); S5L[i] = lv;
            const double nr = lbr - 1.0, ni = lbi, den = lre * lre + lim * lim, fr = (nr * lre + ni * lim) / den, fi = (ni * lre - nr * lim) / den;
            for (int c = 0; c < 16; ++c) { const double br = args.in[I_BRE][(size_t)i * 16 + c], bi = args.in[I_BIM][(size_t)i * 16 + c];
                S5B[(size_t)i * 32 + c] = (float)(fr * br - fi * bi); S5B[(size_t)i * 32 + 16 + c] = (float)(fr * bi + fi * br); } } }
        for (int i = gw * 64 + lane; i < NH * 640; i += NGW * 64) { const int hh = i / 640, y = i % 640; int dd = 575 - y; dd = dd < -256 ? -256 : (dd > 256 ? 256 : dd);
            TAB[i] = 1.4426950408889634f * args.in[I_RB][hh * 513 + dd + 256]; }
    }
    SEAM();

    { constexpr int l = 0;

        const int pb = 1 + 10 * l;
        unsigned char* wl = ws + WS_WL + l * WL_STRIDE;
        float* sq = ssq + (size_t)(4 * l) * M;
        if (l == 1 && IN(pb + 0)) {
            pg8::Gemm g{HB2, (const bf16*)(ws + WS_WKV), M, 2 * D, D, LDH, LDH}; pg8::StaticOrder S; S.init(M, 2 * D, G, G - 1 - bx, 64 * MT_N4096);
            pg8::EpiHead<0, MT_N4096> E{sq, args.in[I_KNG], 1.0f, (PG8_LAS float*)(lds + XCH_OFF), KP, KS, VP, VS, args.out + O_PK, args.out + O_PV, args.out + O_SK, args.out + O_SV, 0};
            pg8::gemm_phase<pg8::EpiHead<0, MT_N4096>, pg8::StaticOrder, true, true, MT_N4096>(lds, g, S, E);
        }
        if (IN(pb + 1)) {
            pg8::Gemm g{l == 0 ? HB : HB2, (const bf16*)(wl + WL_1GU), M, 2 * FF, D, LDH, LDH}; pg8::StaticOrder S; S.init(M, 2 * FF, G, bx, 64 * MT_UP);
            pg8::EpiUp<MT_UP> E{ACT, sq, ACT_BLOCKED ? 0 : LDACT};
            pg8::gemm_phase<pg8::EpiUp<MT_UP>, pg8::StaticOrder, true, SP2_UP, MT_UP>(lds, g, S, E);
        }
        if (IN(pb + 2)) {
            int kple = PLE; asm volatile("" : "+s"(kple));
            pg8::Gemm g{PB + (size_t)l * M * LDPB, (const bf16*)(wl + WL_PP), M, D, kple, LDPB, LDPB}; const pg8::RangeOrder S = proj_tail(G, bx, 0);
            pg8::EpiProj<MT_N2048> E{PROJ, D};
            pg8::gemm_phase<pg8::EpiProj<MT_N2048>, pg8::RangeOrder, true, true, MT_N2048>(lds, g, S, E);
        }
        SEAM();
        if (IN(pb + 3)) {
            pg8::Gemm g{ACT + (size_t)(FF / 64 - 1) * ACT_PR * 64, (const bf16*)(wl + WL_1D) + (FF - 64), M, D, FF, 64, LDACT, -(ACT_PR * 128), -128, ACT_BLOCKED ? (long)(FF / 64) * ACT_PR * 128 : 0L, WD_BLOCKED ? (long)(FF / 64) * 32768 : 0L, ACT_BLOCKED ? ACT_PR * 32 : 0}; pg8::StaticOrder S; S.init(M, D, G, bx, 64 * MT_DOWN, WGM_N2048);
            pg8::EpiRes<0, MT_DOWN, l == 0> E{args.in[I_XP], args.in[I_XS], HB2, nullptr, HB, sq + M, nullptr, nullptr, 0.5f, LDH};
            pg8::gemm_phase<pg8::EpiRes<0, MT_DOWN, l == 0>, pg8::StaticOrder, ALIGN_RES, true, MT_DOWN>(lds, g, S, E);
        }
        SEAM();
        if (IN(pb + 4)) {
            if (l == 0) s5_mfma<true>(HB, sq + M, args.in[I_MIXG], S5L, S5B, args.in[I_CRE], args.in[I_CIM], args.in[I_SD], EST, args.in[I_SRE], args.in[I_SIM], ZQO,
                                  args.out + O_PSRE, args.out + O_PSIM, args.out + O_SSRE, args.out + O_SSIM, (LAS char*)(lds + wave * S5_WAVE_LDS), gw, NGW, lane, true);
            else { pg8::Gemm g{HB, (const bf16*)(ws + WS_WQ), M, D, D, LDH, LDH}; pg8::StaticOrder S; S.init(M, D, G, bx, 64 * MT_N2048, WGM_N2048);
                pg8::EpiHead<1, MT_N2048> E{sq + M, args.in[I_QNG], 0.08838834764831845f * 1.4426950408889634f, (PG8_LAS float*)(lds + XCH_OFF), ZQO, nullptr, nullptr, nullptr, nullptr, nullptr, nullptr, nullptr, LDH};
                pg8::gemm_phase<pg8::EpiHead<1, MT_N2048>, pg8::StaticOrder, true, true, MT_N2048>(lds, g, S, E); }
        }
        SEAM();
        if (l == 0) { if (IN(21)) s5_prefix(S5L, EST, gw, NGW, lane); SEAM(); }
        if (IN(pb + 5)) {
            if (l == 0) s5_mfma<true>(HB, sq + M, args.in[I_MIXG], S5L, S5B, args.in[I_CRE], args.in[I_CIM], args.in[I_SD], EST, args.in[I_SRE], args.in[I_SIM], ZQO,
                                  args.out + O_PSRE, args.out + O_PSIM, args.out + O_SSRE, args.out + O_SSIM, (LAS char*)(lds + wave * S5_WAVE_LDS), gw, NGW, lane, false);
            else {
                for (int ui = vcu; ui < 1024 + 512; ui += G) {
                    if (ui < 1024) { const int qb = ui & 15, hh = (ui >> 4) & 15, b = ui >> 8;
                        att::attn_unit((LAS char*)lds, ZQO, (size_t)b * SEQ + 256 * qb, KP + (size_t)b * SEQ * D, VP + (size_t)b * SEQ * D, hh, 4 * qb, 4, TAB + hh * 640, HB2, tid); }
                    else { const int u2 = ui - 1024, hh = u2 & 15, b = u2 >> 4;
                        att::attn_unit((LAS char*)lds, ZQO, (size_t)MP + b * DSEQ, KS + (size_t)b * SROWS * D, VS + (size_t)b * SROWS * D, hh, 8, 1, TAB + hh * 640, HB2, tid); }
                }
            }
        }
        SEAM();
        if (IN(pb + 6)) {
            if (l == 0) { pg8::Gemm g{ZQO, (const bf16*)(ws + WS_WGLU), M, 2 * D, D, LDH, LDH}; pg8::StaticOrder S; S.init(M, 2 * D, G, bx, 64 * MT_N4096);
                pg8::EpiRes<1, MT_N4096, false> E{nullptr, nullptr, HB, nullptr, HB, sq + 2 * M, nullptr, nullptr, 1.0f, LDH};
                pg8::gemm_phase<pg8::EpiRes<1, MT_N4096, false>, pg8::StaticOrder, ALIGN_RES, true, MT_N4096>(lds, g, S, E); }
            else { pg8::Gemm g{HB2, (const bf16*)(ws + WS_WO), M, D, D, LDH, LDH}; pg8::StaticOrder S; S.init(M, D, G, bx, 64 * MT_N2048, WGM_N2048);
                pg8::EpiRes<0, MT_N2048, false> E{nullptr, nullptr, HB, nullptr, HB, sq + 2 * M, nullptr, nullptr, 1.0f, LDH};
                pg8::gemm_phase<pg8::EpiRes<0, MT_N2048, false>, pg8::StaticOrder, ALIGN_RES, true, MT_N2048>(lds, g, S, E); }
        }
        SEAM();
        if (IN(pb + 7)) {
            pg8::Gemm g{HB, (const bf16*)(wl + WL_2GU), M, 2 * FF, D, LDH, LDH}; pg8::StaticOrder S; S.init(M, 2 * FF, G, bx, 64 * MT_UP);
            pg8::EpiUp<MT_UP> E{ACT, sq + 2 * M, ACT_BLOCKED ? 0 : LDACT};
            pg8::gemm_phase<pg8::EpiUp<MT_UP>, pg8::StaticOrder, true, SP2_UP, MT_UP>(lds, g, S, E);
        }
        if (IN(22 + l)) {
            int kple = PLE; asm volatile("" : "+s"(kple));
            pg8::Gemm g{PB + (size_t)l * M * LDPB, (const bf16*)(wl + WL_PP), M, D, kple, LDPB, LDPB}; const pg8::RangeOrder S = proj_tail(G, bx, 1);
            pg8::EpiProj<MT_N2048> E{PROJ, D};
            pg8::gemm_phase<pg8::EpiProj<MT_N2048>, pg8::RangeOrder, true, true, MT_N2048>(lds, g, S, E);
        }
        SEAM();
        if (IN(pb + 8)) {
            pg8::Gemm g{ACT + (size_t)(FF / 64 - 1) * ACT_PR * 64, (const bf16*)(wl + WL_2D) + (FF - 64), M, D, FF, 64, LDACT, -(ACT_PR * 128), -128, ACT_BLOCKED ? (long)(FF / 64) * ACT_PR * 128 : 0L, WD_BLOCKED ? (long)(FF / 64) * 32768 : 0L, ACT_BLOCKED ? ACT_PR * 32 : 0}; pg8::StaticOrder S; S.init(M, D, G, bx, 64 * MT_DOWN, WGM_N2048);
            pg8::EpiRes<0, MT_DOWN, false> E{nullptr, nullptr, HB, nullptr, HB, sq + 3 * M, nullptr, nullptr, 0.5f, LDH};
            pg8::gemm_phase<pg8::EpiRes<0, MT_DOWN, false>, pg8::StaticOrder, ALIGN_RES, true, MT_DOWN>(lds, g, S, E);
        }
        SEAM();
        if (IN(pb + 9)) {
            pg8::Gemm g{HB, (const bf16*)(wl + WL_PG), M, D, D, LDH, LDH}; pg8::StaticOrder S; S.init(M, D, G, bx, 64 * MT_N2048, WGM_N2048);
            pg8::EpiRes<2, MT_N2048, false> E{nullptr, nullptr, HB, l == 0 ? nullptr : Hres, l == 0 ? HB2 : nullptr, l == 0 ? sq + 4 * M : nullptr, sq + 3 * M, PROJ, 1.0f, LDH};
            pg8::gemm_phase<pg8::EpiRes<2, MT_N2048, false>, pg8::StaticOrder, ALIGN_RES, true, MT_N2048>(lds, g, S, E);
        }
        if (l == 0) SEAM();
        }
    { constexpr int l = 1;

        const int pb = 1 + 10 * l;
        unsigned char* wl = ws + WS_WL + l * WL_STRIDE;
        float* sq = ssq + (size_t)(4 * l) * M;
        if (l == 1 && IN(pb + 0)) {
            pg8::Gemm g{HB2, (const bf16*)(ws + WS_WKV), M, 2 * D, D, LDH, LDH}; pg8::StaticOrder S; S.init(M, 2 * D, G, G - 1 - bx, 64 * MT_N4096);
            pg8::EpiHead<0, MT_N4096> E{sq, args.in[I_KNG], 1.0f, (PG8_LAS float*)(lds + XCH_OFF), KP, KS, VP, VS, args.out + O_PK, args.out + O_PV, args.out + O_SK, args.out + O_SV, 0};
            pg8::gemm_phase<pg8::EpiHead<0, MT_N4096>, pg8::StaticOrder, true, true, MT_N4096>(lds, g, S, E);
        }
        if (IN(pb + 1)) {
            pg8::Gemm g{l == 0 ? HB : HB2, (const bf16*)(wl + WL_1GU), M, 2 * FF, D, LDH, LDH}; pg8::StaticOrder S; S.init(M, 2 * FF, G, bx, 64 * MT_UP);
            pg8::EpiUp<MT_UP> E{ACT, sq, ACT_BLOCKED ? 0 : LDACT};
            pg8::gemm_phase<pg8::EpiUp<MT_UP>, pg8::StaticOrder, true, SP2_UP, MT_UP>(lds, g, S, E);
        }
        if (IN(pb + 2)) {
            int kple = PLE; asm volatile("" : "+s"(kple));
            pg8::Gemm g{PB + (size_t)l * M * LDPB, (const bf16*)(wl + WL_PP), M, D, kple, LDPB, LDPB}; const pg8::RangeOrder S = proj_tail(G, bx, 0);
            pg8::EpiProj<MT_N2048> E{PROJ, D};
            pg8::gemm_phase<pg8::EpiProj<MT_N2048>, pg8::RangeOrder, true, true, MT_N2048>(lds, g, S, E);
        }
        SEAM();
        if (IN(pb + 3)) {
            pg8::Gemm g{ACT + (size_t)(FF / 64 - 1) * ACT_PR * 64, (const bf16*)(wl + WL_1D) + (FF - 64), M, D, FF, 64, LDACT, -(ACT_PR * 128), -128, ACT_BLOCKED ? (long)(FF / 64) * ACT_PR * 128 : 0L, WD_BLOCKED ? (long)(FF / 64) * 32768 : 0L, ACT_BLOCKED ? ACT_PR * 32 : 0}; pg8::StaticOrder S; S.init(M, D, G, bx, 64 * MT_DOWN, WGM_N2048);
            pg8::EpiRes<0, MT_DOWN, l == 0> E{args.in[I_XP], args.in[I_XS], HB2, nullptr, HB, sq + M, nullptr, nullptr, 0.5f, LDH};
            pg8::gemm_phase<pg8::EpiRes<0, MT_DOWN, l == 0>, pg8::StaticOrder, ALIGN_RES, true, MT_DOWN>(lds, g, S, E);
        }
        SEAM();
        if (IN(pb + 4)) {
            if (l == 0) s5_mfma<true>(HB, sq + M, args.in[I_MIXG], S5L, S5B, args.in[I_CRE], args.in[I_CIM], args.in[I_SD], EST, args.in[I_SRE], args.in[I_SIM], ZQO,
                                  args.out + O_PSRE, args.out + O_PSIM, args.out + O_SSRE, args.out + O_SSIM, (LAS char*)(lds + wave * S5_WAVE_LDS), gw, NGW, lane, true);
            else { pg8::Gemm g{HB, (const bf16*)(ws + WS_WQ), M, D, D, LDH, LDH}; pg8::StaticOrder S; S.init(M, D, G, bx, 64 * MT_N2048, WGM_N2048);
                pg8::EpiHead<1, MT_N2048> E{sq + M, args.in[I_QNG], 0.08838834764831845f * 1.4426950408889634f, (PG8_LAS float*)(lds + XCH_OFF), ZQO, nullptr, nullptr, nullptr, nullptr, nullptr, nullptr, nullptr, LDH};
                pg8::gemm_phase<pg8::EpiHead<1, MT_N2048>, pg8::StaticOrder, true, true, MT_N2048>(lds, g, S, E); }
        }
        SEAM();
        if (l == 0) { if (IN(21)) s5_prefix(S5L, EST, gw, NGW, lane); SEAM(); }
        if (IN(pb + 5)) {
            if (l == 0) s5_mfma<true>(HB, sq + M, args.in[I_MIXG], S5L, S5B, args.in[I_CRE], args.in[I_CIM], args.in[I_SD], EST, args.in[I_SRE], args.in[I_SIM], ZQO,
                                  args.out + O_PSRE, args.out + O_PSIM, args.out + O_SSRE, args.out + O_SSIM, (LAS char*)(lds + wave * S5_WAVE_LDS), gw, NGW, lane, false);
            else {
                for (int ui = vcu; ui < 1024 + 512; ui += G) {
                    if (ui < 1024) { const int qb = ui & 15, hh = (ui >> 4) & 15, b = ui >> 8;
                        att::attn_unit((LAS char*)lds, ZQO, (size_t)b * SEQ + 256 * qb, KP + (size_t)b * SEQ * D, VP + (size_t)b * SEQ * D, hh, 4 * qb, 4, TAB + hh * 640, HB2, tid); }
                    else { const int u2 = ui - 1024, hh = u2 & 15, b = u2 >> 4;
                        att::attn_unit((LAS char*)lds, ZQO, (size_t)MP + b * DSEQ, KS + (size_t)b * SROWS * D, VS + (size_t)b * SROWS * D, hh, 8, 1, TAB + hh * 640, HB2, tid); }
                }
            }
        }
        SEAM();
        if (IN(pb + 6)) {
            if (l == 0) { pg8::Gemm g{ZQO, (const bf16*)(ws + WS_WGLU), M, 2 * D, D, LDH, LDH}; pg8::StaticOrder S; S.init(M, 2 * D, G, bx, 64 * MT_N4096);
                pg8::EpiRes<1, MT_N4096, false> E{nullptr, nullptr, HB, nullptr, HB, sq + 2 * M, nullptr, nullptr, 1.0f, LDH};
                pg8::gemm_phase<pg8::EpiRes<1, MT_N4096, false>, pg8::StaticOrder, ALIGN_RES, true, MT_N4096>(lds, g, S, E); }
            else { pg8::Gemm g{HB2, (const bf16*)(ws + WS_WO), M, D, D, LDH, LDH}; pg8::StaticOrder S; S.init(M, D, G, bx, 64 * MT_N2048, WGM_N2048);
                pg8::EpiRes<0, MT_N2048, false> E{nullptr, nullptr, HB, nullptr, HB, sq + 2 * M, nullptr, nullptr, 1.0f, LDH};
                pg8::gemm_phase<pg8::EpiRes<0, MT_N2048, false>, pg8::StaticOrder, ALIGN_RES, true, MT_N2048>(lds, g, S, E); }
        }
        SEAM();
        if (IN(pb + 7)) {
            pg8::Gemm g{HB, (const bf16*)(wl + WL_2GU), M, 2 * FF, D, LDH, LDH}; pg8::StaticOrder S; S.init(M, 2 * FF, G, bx, 64 * MT_UP);
            pg8::EpiUp<MT_UP> E{ACT, sq + 2 * M, ACT_BLOCKED ? 0 : LDACT};
            pg8::gemm_phase<pg8::EpiUp<MT_UP>, pg8::StaticOrder, true, SP2_UP, MT_UP>(lds, g, S, E);
        }
        if (IN(22 + l)) {
            int kple = PLE; asm volatile("" : "+s"(kple));
            pg8::Gemm g{PB + (size_t)l * M * LDPB, (const bf16*)(wl + WL_PP), M, D, kple, LDPB, LDPB}; const pg8::RangeOrder S = proj_tail(G, bx, 1);
            pg8::EpiProj<MT_N2048> E{PROJ, D};
            pg8::gemm_phase<pg8::EpiProj<MT_N2048>, pg8::RangeOrder, true, true, MT_N2048>(lds, g, S, E);
        }
        SEAM();
        if (IN(pb + 8)) {
            pg8::Gemm g{ACT + (size_t)(FF / 64 - 1) * ACT_PR * 64, (const bf16*)(wl + WL_2D) + (FF - 64), M, D, FF, 64, LDACT, -(ACT_PR * 128), -128, ACT_BLOCKED ? (long)(FF / 64) * ACT_PR * 128 : 0L, WD_BLOCKED ? (long)(FF / 64) * 32768 : 0L, ACT_BLOCKED ? ACT_PR * 32 : 0}; pg8::StaticOrder S; S.init(M, D, G, bx, 64 * MT_DOWN, WGM_N2048);
            pg8::EpiRes<0, MT_DOWN, false> E{nullptr, nullptr, HB, nullptr, HB, sq + 3 * M, nullptr, nullptr, 0.5f, LDH};
            pg8::gemm_phase<pg8::EpiRes<0, MT_DOWN, false>, pg8::StaticOrder, ALIGN_RES, true, MT_DOWN>(lds, g, S, E);
        }
        SEAM();
        if (IN(pb + 9)) {
            pg8::Gemm g{HB, (const bf16*)(wl + WL_PG), M, D, D, LDH, LDH}; pg8::StaticOrder S; S.init(M, D, G, bx, 64 * MT_N2048, WGM_N2048);
            pg8::EpiRes<2, MT_N2048, false> E{nullptr, nullptr, HB, l == 0 ? nullptr : Hres, l == 0 ? HB2 : nullptr, l == 0 ? sq + 4 * M : nullptr, sq + 3 * M, PROJ, 1.0f, LDH};
            pg8::gemm_phase<pg8::EpiRes<2, MT_N2048, false>, pg8::StaticOrder, ALIGN_RES, true, MT_N2048>(lds, g, S, E);
        }
        if (l == 0) SEAM();
        }
#undef IN
#undef SEAM
}

extern "C" void kernel_launch(void* const* d_in, const int* in_sizes, int n_in, void* d_out, int out_size, void* d_ws, size_t ws_size, hipStream_t stream) {
    static int grid = 0;
    if (grid == 0) {
        if (n_in != 38 || out_size != (int)O_END || ws_size < WS_END) { fprintf(stderr, "kernel_launch: unexpected shapes (n_in %d, out %d, ws %zu)\n", n_in, out_size, ws_size); grid = -1; return; }
        int dev = 0, cus = 0, per_cu = 0;
        if (hipGetDevice(&dev) != hipSuccess || hipDeviceGetAttribute(&cus, hipDeviceAttributeMultiprocessorCount, dev) != hipSuccess) { grid = -1; return; }
        if (hipFuncSetAttribute((const void*)mega_fwd, hipFuncAttributeMaxDynamicSharedMemorySize, LDS_BYTES) != hipSuccess) { fprintf(stderr, "kernel_launch: hipFuncSetAttribute failed\n"); grid = -1; return; }
        if (hipOccupancyMaxActiveBlocksPerMultiprocessor(&per_cu, (const void*)mega_fwd, NWAVES * 64, LDS_BYTES) != hipSuccess || per_cu < 1) { fprintf(stderr, "kernel_launch: occupancy query says %d\n", per_cu); }
        (void)hipGetLastError();
        grid = cus;
    }
    if (grid < 0) return;
    if (hipMemsetAsync((char*)d_ws + WS_CTL, 0, CTL_ZERO_BYTES, stream) != hipSuccess) return;
    Args a{};
    for (int i = 0; i < 38; ++i) a.in[i] = (const float*)d_in[i];
    a.out = (float*)d_out; a.ws = (unsigned char*)d_ws;
#if MK_ONE_LAUNCH
    a.ph_lo = 0; a.ph_hi = N_PHASES;
    hipLaunchKernelGGL(mega_fwd, dim3(grid), dim3(NWAVES * 64), LDS_BYTES, stream, a);
#else
    static const int order[23] = {0, 2, 3, 4, 5, 21, 6, 7, 8, 22, 9, 10, 11, 12, 13, 14, 15, 16, 17, 18, 23, 19, 20};
    for (int oi = 0; oi < 23; ++oi) { const int p = order[oi]; a.ph_lo = p; a.ph_hi = p + 1; int reps = 1;
        for (int r = 0; r < reps; ++r) hipLaunchKernelGGL(mega_fwd, dim3(grid), dim3(NWAVES * 64), LDS_BYTES, stream, a); }
#endif
}
```

```cpp
#include <hip/hip_runtime.h>
#include <cstdio>
#include <cstdint>
namespace pg8 {
#define PG8_LAS __attribute__((address_space(3)))
typedef unsigned short bf16_t;
typedef short bf16x8 __attribute__((ext_vector_type(8)));
typedef float f32x4 __attribute__((ext_vector_type(4)));
typedef unsigned u32x4 __attribute__((ext_vector_type(4)));
constexpr int BM = 256, BK = 64, HALF = 128, HTB = HALF * BK * 2  , STAGE_BYTES = 8 * HTB, NXCD = 8, WGM = 8;

__host__ __device__ __forceinline__ int lds_byte(int r, int c) { const int st = (r >> 4) * 2 + (c >> 5), rr = r & 15, cc = c & 31, ob = rr * 64 + cc * 2; return st * 1024 + (ob ^ (((ob >> 9) & 1) << 5)); }
__host__ __device__ __forceinline__ void stage_rc(int b, int& R, int& C) { const int st = b / 1024, sb = b % 1024, swz = sb ^ (((sb >> 9) & 1) << 5); R = (st >> 1) * 16 + swz / 64; C = (st & 1) * 32 + (swz % 64) / 2; }
__host__ __device__ __forceinline__ int perm32(int rho) { const int n = rho >> 4, i = rho & 15; return 8 * (i >> 2) + 4 * n + (i & 3); }

struct Unit { int pm, pn; };
struct Gemm { const bf16_t* A; const bf16_t* Bt; int M, N, K, lda, ldb; int ksA = 0, ksB = 0; long tsA = 0, tsB = 0; int sbA = 0; };

struct RangeOrder {
    int first, count, nN;
    __host__ __device__ bool next(int i, Unit& u) const { if (i >= count) return false; const int id = first + i; u.pm = id / nN; u.pn = id - u.pm * nN; return true; }
    __device__ __forceinline__ void a_ready(const Unit&) const {}
    __device__ __forceinline__ void done(const Unit&) const {}
};
struct StaticOrder {
    int nM, nN, nwg, G, c, wgm;
    __host__ __device__ void init(int M, int N, int G_, int c_, int bm = BM, int wgm_ = WGM) { nM = M / bm; nN = N / BM; nwg = nM * nN; G = G_; c = c_; wgm = wgm_; }
    __host__ __device__ bool next(int i, Unit& u) const {
        const long L = (long)i * G + c; if (L >= nwg) return false;
        int wgid = (int)L; { const int q = nwg / NXCD, r = nwg % NXCD, xcd = wgid % NXCD, off = wgid / NXCD; wgid = (xcd < r ? xcd * (q + 1) : r * (q + 1) + (xcd - r) * q) + off; }
        const int nig = wgm * nN, gid = wgid / nig, fm = gid * wgm, gsz = (nM - fm) < wgm ? (nM - fm) : wgm;
        u.pm = fm + ((wgid % nig) % gsz); u.pn = (wgid % nig) / gsz; return true;
    }
    __device__ __forceinline__ void a_ready(const Unit&) const {}
    __device__ __forceinline__ void done(const Unit&) const {}
};

typedef float f32x2 __attribute__((ext_vector_type(2)));
typedef unsigned u32x2 __attribute__((ext_vector_type(2)));
typedef __bf16 bf16x2_t __attribute__((ext_vector_type(2)));
__device__ __forceinline__ unsigned cvt_pk_bf16(float lo, float hi) { f32x2 v = {lo, hi}; bf16x2_t b = __builtin_convertvector(v, bf16x2_t); return __builtin_bit_cast(unsigned, b); }
__device__ __forceinline__ float sigm(float x) { return __builtin_amdgcn_rcpf(1.0f + __builtin_amdgcn_exp2f(-1.4426950408889634f * x)); }
__device__ __forceinline__ f32x4 sigm4(f32x4 x) { f32x4 r; r[0] = sigm(x[0]); r[1] = sigm(x[1]); r[2] = sigm(x[2]); r[3] = sigm(x[3]); return r; }
constexpr int MTOK = 18432, MPROMPT = 16384, DM = 2048, FFH = 5632;
#ifndef ACT_PR
#define ACT_PR 192
#endif
constexpr float RMS_EPS = 1e-6f;

template <int MT> struct EpiUp {
    static constexpr bool PERM = true, AFTER_DRAIN = false;
    bf16_t* O; const float* ssq; int ldo;
    __device__ __forceinline__ void operator()(const f32x4 (&acc)[2][2][MT][2], const Unit& u, int wr, int wc, int fr, int fq) const {
        const int row0 = u.pm * (64 * MT) + wr * (16 * MT) + fr, col0 = u.pn * HALF + wc * 32 + 8 * fq;
        float sv[2][MT];
#pragma unroll
        for (int ai = 0; ai < 2; ++ai)
#pragma unroll
            for (int m = 0; m < MT; ++m) sv[ai][m] = ssq[row0 + ai * (32 * MT) + m * 16];
#pragma unroll
        for (int ai = 0; ai < 2; ++ai)
#pragma unroll
            for (int m = 0; m < MT; ++m) {
                const int row = row0 + ai * (32 * MT) + m * 16;
                const float rs = rsqrtf(sv[ai][m] * (1.0f / 2048.0f) + RMS_EPS);
                const f32x4 g0 = acc[ai][0][m][0] * rs, g1 = acc[ai][0][m][1] * rs, u0 = acc[ai][1][m][0] * rs, u1 = acc[ai][1][m][1] * rs;
                const f32x4 o0 = g0 * sigm4(g0) * u0, o1 = g1 * sigm4(g1) * u1;
                u32x4 w; w.x = cvt_pk_bf16(o0[0], o0[1]); w.y = cvt_pk_bf16(o0[2], o0[3]); w.z = cvt_pk_bf16(o1[0], o1[1]); w.w = cvt_pk_bf16(o1[2], o1[3]);
                if (ldo) *(u32x4*)(O + (size_t)row * ldo + col0) = w;
                else { const int pnl = row / ACT_PR, rr = row - pnl * ACT_PR;
                    *(u32x4*)((char*)O + (size_t)pnl * ((FFH / 32) * ACT_PR * 64) + (size_t)(col0 >> 5) * (ACT_PR * 64) + rr * 64 + (col0 & 31) * 2) = w; }
            }
    }
};
template <int MT> struct EpiProj {
    static constexpr bool PERM = true, AFTER_DRAIN = false;
    bf16_t* O; int ldo;
    __device__ __forceinline__ void operator()(const f32x4 (&acc)[2][2][MT][2], const Unit& u, int wr, int wc, int fr, int fq) const {
        const int row0 = u.pm * (64 * MT) + wr * (16 * MT) + fr, col0 = u.pn * BM + wc * 32 + 8 * fq;
#pragma unroll
        for (int ai = 0; ai < 2; ++ai)
#pragma unroll
            for (int m = 0; m < MT; ++m) {
                bf16_t* rowp = O + (size_t)(row0 + ai * (32 * MT) + m * 16) * ldo + col0;
#pragma unroll
                for (int bj = 0; bj < 2; ++bj) { const f32x4 v0 = acc[ai][bj][m][0], v1 = acc[ai][bj][m][1];
                    u32x4 w; w.x = cvt_pk_bf16(v0[0], v0[1]); w.y = cvt_pk_bf16(v0[2], v0[3]); w.z = cvt_pk_bf16(v1[0], v1[1]); w.w = cvt_pk_bf16(v1[2], v1[3]);
                    *(u32x4*)(rowp + bj * HALF) = w; }
            }
    }
};
__device__ __forceinline__ f32x4 bf4_to_f32(u32x2 w) { f32x4 v; v[0] = __uint_as_float(w.x << 16); v[1] = __uint_as_float(w.x & 0xffff0000u); v[2] = __uint_as_float(w.y << 16); v[3] = __uint_as_float(w.y & 0xffff0000u); return v; }
template <int MODE, int MT, bool BASEF32> struct EpiRes {
    static constexpr bool PERM = true, AFTER_DRAIN = false;
    const float* baseP; const float* baseS; const bf16_t* baseHb; float* outH; bf16_t* outHb; float* ssq_out; const float* ssq_in; const bf16_t* proj; float scale; int ldhb;
    __device__ __forceinline__ void operator()(const f32x4 (&acc)[2][2][MT][2], const Unit& u, int wr, int wc, int fr, int fq) const {
        asm volatile("" : "+v"(fr), "+v"(fq));
        constexpr int NB = (MODE == 1) ? 1 : 2;
        constexpr int MB = (MT == 4) ? 2 : ((MODE == 2) ? 1 : 3);
        const int row0 = u.pm * (64 * MT) + wr * (16 * MT) + fr;
        const int col0 = (MODE == 1 ? u.pn * HALF : u.pn * BM) + wc * 32 + 8 * fq;
#pragma unroll
        for (int ai = 0; ai < 2; ++ai)
#pragma unroll
            for (int mb = 0; mb < MT; mb += MB) {
                f32x4 hb[MB][NB][2]; u32x4 hw[MB][NB]; u32x4 pj[MB][NB]; float sv[MB];
#pragma unroll
                for (int mm = 0; mm < MB; ++mm) {
                    const int row = row0 + ai * (32 * MT) + (mb + mm) * 16;
                    if (MODE == 2) sv[mm] = ssq_in[row];
#pragma unroll
                    for (int bj = 0; bj < NB; ++bj) { const int cc = col0 + bj * HALF;
                        if (BASEF32) { const float* xp = (row < MPROMPT ? baseP : baseS - (size_t)MPROMPT * DM) + (size_t)row * DM + cc; hb[mm][bj][0] = *(const f32x4*)xp; hb[mm][bj][1] = *(const f32x4*)(xp + 4); }
                        else hw[mm][bj] = *(const u32x4*)(baseHb + (size_t)row * ldhb + cc);
                        if (MODE == 2) pj[mm][bj] = *(const u32x4*)(proj + (size_t)row * DM + cc); }
                }
#pragma unroll
                for (int mm = 0; mm < MB; ++mm) {
                    const int m = mb + mm, row = row0 + ai * (32 * MT) + m * 16;
                    float rs = 1.f; if (MODE == 2) rs = rsqrtf(sv[mm] * (1.0f / 2048.0f) + RMS_EPS);
                    float s = 0.f;
#pragma unroll
                    for (int bj = 0; bj < NB; ++bj) {
                        const int cc = col0 + bj * HALF;
                        f32x4 hn[2];
#pragma unroll
                        for (int n = 0; n < 2; ++n) {
                            f32x4 val;
                            if (MODE == 0) val = acc[ai][bj][m][n] * scale;
                            else if (MODE == 1) val = acc[ai][0][m][n] * sigm4(acc[ai][1][m][n]);
                            else { u32x2 pw; pw.x = n ? pj[mm][bj].z : pj[mm][bj].x; pw.y = n ? pj[mm][bj].w : pj[mm][bj].y; val = bf4_to_f32(pw) * sigm4(acc[ai][bj][m][n] * rs); }
                            f32x4 bs;
                            if (BASEF32) bs = hb[mm][bj][n];
                            else { u32x2 bw; bw.x = n ? hw[mm][bj].z : hw[mm][bj].x; bw.y = n ? hw[mm][bj].w : hw[mm][bj].y; bs = bf4_to_f32(bw); }
                            hn[n] = bs + val;
                            s += (hn[n][0] * hn[n][0] + hn[n][1] * hn[n][1]) + (hn[n][2] * hn[n][2] + hn[n][3] * hn[n][3]);
                        }
                        if (outH) { float* op = outH + (size_t)row * DM + cc; *(f32x4*)op = hn[0]; *(f32x4*)(op + 4) = hn[1]; }
                        if (outHb) { u32x4 w; w.x = cvt_pk_bf16(hn[0][0], hn[0][1]); w.y = cvt_pk_bf16(hn[0][2], hn[0][3]); w.z = cvt_pk_bf16(hn[1][0], hn[1][1]); w.w = cvt_pk_bf16(hn[1][2], hn[1][3]);
                            *(u32x4*)(outHb + (size_t)row * ldhb + cc) = w; }
                    }
                    if (ssq_out) { s += __shfl_xor(s, 16); s += __shfl_xor(s, 32); if (fq == 0) unsafeAtomicAdd(ssq_out + row, s); }
                }
                asm volatile("" ::: "memory");
            }
    }
};
template <int KIND, int MT> struct EpiHead {
    static constexpr bool PERM = true, AFTER_DRAIN = false;
    const float* ssq_in; const float* gain; float qscale; PG8_LAS float* xch;
    bf16_t* kP; bf16_t* kS; bf16_t* vP; bf16_t* vS; float* o_pk; float* o_pv; float* o_sk; float* o_sv; int ldq;
    __device__ __forceinline__ void operator()(const f32x4 (&acc)[2][2][MT][2], const Unit& u, int wr, int wc, int fr, int fq) const {
        asm volatile("" : "+v"(fr), "+v"(fq));
        const bool isV = (KIND == 0) && (u.pn >= 8);
        const int rl0 = wr * (16 * MT) + fr;
#pragma unroll
        for (int ai = 0; ai < 2; ++ai)
#pragma unroll
            for (int m = 0; m < MT; ++m) {
                const int rl = rl0 + ai * (32 * MT) + m * 16;

#pragma unroll
                for (int bj = 0; bj < 2; ++bj) {
                    const f32x4 a = acc[ai][bj][m][0], b = acc[ai][bj][m][1];
                    float s = (a[0] * a[0] + a[1] * a[1]) + (a[2] * a[2] + a[3] * a[3]) + (b[0] * b[0] + b[1] * b[1]) + (b[2] * b[2] + b[3] * b[3]);
                    s += __shfl_xor(s, 16); s += __shfl_xor(s, 32);
                    if (fq == 0) xch[(bj * 256 + rl) * 4 + wc] = s;
                }
            }
        asm volatile("s_waitcnt lgkmcnt(0)" ::: "memory"); __builtin_amdgcn_s_barrier(); asm volatile("" ::: "memory");
        const int cw = wc * 32 + 8 * fq;
        const int ct = (u.pn & 7) * BM + cw;
        float sv[2][MT];
#pragma unroll
        for (int ai = 0; ai < 2; ++ai)
#pragma unroll
            for (int m = 0; m < MT; ++m) sv[ai][m] = ssq_in[u.pm * (64 * MT) + rl0 + ai * (32 * MT) + m * 16];
#pragma unroll
        for (int ai = 0; ai < 2; ++ai)
#pragma unroll
            for (int m = 0; m < MT; ++m) {
                const int rl = rl0 + ai * (32 * MT) + m * 16, row = u.pm * (64 * MT) + rl;
                const float rs = rsqrtf(sv[ai][m] * (1.0f / 2048.0f) + RMS_EPS);
                bf16_t* dst; float* fdst = nullptr;
                if (KIND == 1) dst = kP + (size_t)row * ldq;
                else if (row < MPROMPT) { dst = (isV ? vP : kP) + (size_t)row * DM; const int t = row & 4095; if (t >= 3584) fdst = (isV ? o_pv : o_pk) + (size_t)((row >> 12) * 512 + t - 3584) * DM; }
                else { const int r2 = row - MPROMPT; dst = (isV ? vS : kS) + (size_t)((r2 >> 6) * 576 + 512 + (r2 & 63)) * DM; fdst = (isV ? o_sv : o_sk) + (size_t)r2 * DM; }
#pragma unroll
                for (int bj = 0; bj < 2; ++bj) {
                    const f32x4 ps = *(const PG8_LAS f32x4*)(xch + (bj * 256 + rl) * 4);
                    float sc = rs;
                    if (!isV) { const float ss = ((ps[0] + ps[1]) + (ps[2] + ps[3])) * rs * rs; sc = rs * rsqrtf(ss * (1.0f / 128.0f) + RMS_EPS) * qscale; }
                    f32x4 v0 = acc[ai][bj][m][0] * sc, v1 = acc[ai][bj][m][1] * sc;
                    if (!isV) { v0 = v0 * *(const f32x4*)(gain + cw); v1 = v1 * *(const f32x4*)(gain + cw + 4); }
                    u32x4 w; w.x = cvt_pk_bf16(v0[0], v0[1]); w.y = cvt_pk_bf16(v0[2], v0[3]); w.z = cvt_pk_bf16(v1[0], v1[1]); w.w = cvt_pk_bf16(v1[2], v1[3]);
                    *(u32x4*)(dst + ct + bj * HALF) = w;
                    if (KIND == 0 && fdst) { *(f32x4*)(fdst + ct + bj * HALF) = v0; *(f32x4*)(fdst + ct + bj * HALF + 4) = v1; }
                }
            }
    }
};
template <class Epi, class Sched, bool ALIGN_EPI = false, bool SP2 = false, int MT = 4>
__device__ __forceinline__ void gemm_phase(PG8_LAS unsigned char* lds, const Gemm g, const Sched& S, const Epi& E) {
    int tid = threadIdx.x; asm volatile("" : "+v"(tid));
    const int wid = __builtin_amdgcn_readfirstlane(tid >> 6), lane = tid & 63, wr = wid >> 2, wc = wid & 3, fr = lane & 15, fq = lane >> 4;
    const int K = g.K, nt = K / BK, lda = g.lda, ldb = g.ldb; constexpr int HA = 32 * MT;
    unsigned voffA[2], voffB[2];
#pragma unroll
    for (int i = 0; i < 2; ++i) { int R, C; stage_rc(tid * 16 + i * 8192, R, C); const int Rb = Epi::PERM ? ((R & ~31) + perm32(R & 31)) : R;
        const int Ra = (R >= HA) ? R - 32 : R; voffA[i] = g.sbA ? (unsigned)((C >> 5) * g.sbA + Ra * 32 + (C & 31)) * 2u : (unsigned)(Ra * lda + C) * 2u; voffB[i] = (unsigned)(Rb * ldb + C) * 2u; }
    const size_t kstepA = g.ksA ? (size_t)g.ksA : (size_t)(BK * 2), kstepB = g.ksB ? (size_t)g.ksB : (size_t)(BK * 2);
    const size_t hstepA = g.sbA ? (size_t)HA * 64 : (size_t)HA * lda * 2, hstepB = (size_t)HALF * ldb * 2;
    const size_t tstepA = g.tsA ? (size_t)g.tsA : 2 * hstepA, tstepB = g.tsB ? (size_t)g.tsB : 2 * hstepB;
    const unsigned ldsw = (unsigned)wid * 1024u;
    const int aoff = lds_byte(wr * (16 * MT) + fr, fq * 8), boff = lds_byte(wc * 32 + fr, fq * 8);
#define PG8_SA(b, h) (((b) * 2 + (h)) * HTB)
#define PG8_SB(b, h) ((4 + (b) * 2 + (h)) * HTB)
#define PG8_STAGE(bufoff, gbase, voff) do { _Pragma("unroll") for (int _i = 0; _i < 2; ++_i) \
        __builtin_amdgcn_global_load_lds((const unsigned*)((const char*)(gbase) + (voff)[_i]), (PG8_LAS unsigned*)(lds + (bufoff) + ldsw + _i * 8192), 16, 0, 0); } while (0)
#define PG8_LDA(dst, b, h) do { _Pragma("unroll") for (int m = 0; m < MT; ++m) _Pragma("unroll") for (int k = 0; k < 2; ++k) dst[m][k] = *(const PG8_LAS bf16x8*)(lds + PG8_SA(b, h) + aoff + m * 2048 + k * 1024); } while (0)
#define PG8_LDB(dst, b, h) do { _Pragma("unroll") for (int n = 0; n < 2; ++n) _Pragma("unroll") for (int k = 0; k < 2; ++k) dst[n][k] = *(const PG8_LAS bf16x8*)(lds + PG8_SB(b, h) + boff + n * 2048 + k * 1024); } while (0)
#define PG8_MMA(ai, bj, At, Bt) do { __builtin_amdgcn_s_setprio(1); _Pragma("unroll") for (int m = 0; m < MT; ++m) _Pragma("unroll") for (int n = 0; n < 2; ++n) _Pragma("unroll") for (int k = 0; k < 2; ++k) \
        acc[ai][bj][m][n] = __builtin_amdgcn_mfma_f32_16x16x32_bf16(Bt[n][k], At[m][k], acc[ai][bj][m][n], 0, 0, 0); __builtin_amdgcn_s_setprio(0); } while (0)
#define PG8_WAIT_V(n) asm volatile("s_waitcnt vmcnt(" #n ")" ::: "memory")
#define PG8_WAIT_L(n) asm volatile("s_waitcnt lgkmcnt(" #n ")" ::: "memory")
#define PG8_BAR __builtin_amdgcn_s_barrier()
#define PG8_SCHED __builtin_amdgcn_sched_barrier(0)
    Unit cur, nxt; int ui = 0;
    if (!S.next(0, cur)) return;
    f32x4 acc[2][2][MT][2];
#pragma unroll
    for (int a = 0; a < 2; ++a)
#pragma unroll
        for (int b = 0; b < 2; ++b)
#pragma unroll
            for (int m = 0; m < MT; ++m)
#pragma unroll
                for (int n = 0; n < 2; ++n) acc[a][b][m][n] = (f32x4){0.f, 0.f, 0.f, 0.f};
    bf16x8 At[MT][2], B0[2][2], B1[2][2];
    const char* cA = (const char*)g.A + (size_t)cur.pm * tstepA; const char* cB = (const char*)g.Bt + (size_t)cur.pn * tstepB;
    S.a_ready(cur);
    if constexpr (SP2) {
        PG8_STAGE(PG8_SB(0, 0), cB, voffB); PG8_STAGE(PG8_SB(0, 1), cB + hstepB, voffB); PG8_STAGE(PG8_SA(0, 0), cA, voffA); PG8_STAGE(PG8_SA(0, 1), cA + hstepA, voffA);
        if (wr == 1) PG8_BAR;
        PG8_WAIT_V(2); PG8_BAR;
        PG8_STAGE(PG8_SB(1, 0), cB + kstepB, voffB); PG8_STAGE(PG8_SA(1, 0), cA + kstepA, voffA); PG8_STAGE(PG8_SB(1, 1), cB + hstepB + kstepB, voffB);
        PG8_WAIT_V(6); PG8_BAR;
    } else {
        PG8_STAGE(PG8_SB(0, 0), cB, voffB); PG8_STAGE(PG8_SA(0, 0), cA, voffA); PG8_STAGE(PG8_SB(0, 1), cB + hstepB, voffB); PG8_STAGE(PG8_SA(0, 1), cA + hstepA, voffA);
        if (wr == 1) PG8_BAR;
        PG8_WAIT_V(4); PG8_BAR;
        PG8_STAGE(PG8_SB(1, 0), cB + kstepB, voffB); PG8_STAGE(PG8_SA(1, 0), cA + kstepA, voffA); PG8_STAGE(PG8_SB(1, 1), cB + hstepB + kstepB, voffB);
        PG8_WAIT_V(6); PG8_BAR;
    }
    for (;;) {
        const bool has_next = S.next(ui + 1, nxt);
        const char* nA = has_next ? (const char*)g.A + (size_t)nxt.pm * tstepA : cA; const char* nB = has_next ? (const char*)g.Bt + (size_t)nxt.pn * tstepB : cB;
        for (int t = 0; t < nt; t += 2) {
            const bool last = (t == nt - 2);
            const char* a1 = cA + (size_t)(t + 1) * kstepA;
            const char* a2 = last ? nA : cA + (size_t)(t + 2) * kstepA; const char* b2 = last ? nB : cB + (size_t)(t + 2) * kstepB;
            const char* a3 = a2 + kstepA; const char* b3 = b2 + kstepB;
            if (last && has_next) S.a_ready(nxt);
            if constexpr (SP2) {
            PG8_LDB(B0, 0, 0); PG8_LDB(B1, 0, 1); PG8_SCHED; PG8_LDA(At, 0, 0); PG8_STAGE(PG8_SA(1, 1), a1 + hstepA, voffA);
            PG8_WAIT_V(8); PG8_WAIT_L(0); PG8_BAR; PG8_MMA(0, 0, At, B0); PG8_MMA(0, 1, At, B1); PG8_BAR; PG8_SCHED;
            PG8_LDA(At, 0, 1); PG8_STAGE(PG8_SB(0, 0), b2, voffB); PG8_STAGE(PG8_SB(0, 1), b2 + hstepB, voffB); PG8_STAGE(PG8_SA(0, 0), a2, voffA);
            PG8_WAIT_V(8); PG8_WAIT_L(0); PG8_BAR; PG8_MMA(1, 0, At, B0); PG8_MMA(1, 1, At, B1); PG8_BAR; PG8_SCHED;
            PG8_LDB(B0, 1, 0); PG8_LDB(B1, 1, 1); PG8_SCHED; PG8_LDA(At, 1, 0); PG8_STAGE(PG8_SA(0, 1), a2 + hstepA, voffA);
            PG8_WAIT_V(8); PG8_WAIT_L(0); PG8_BAR; PG8_MMA(0, 0, At, B0); PG8_MMA(0, 1, At, B1); PG8_BAR; PG8_SCHED;
            PG8_LDA(At, 1, 1); PG8_STAGE(PG8_SB(1, 0), b3, voffB); PG8_STAGE(PG8_SB(1, 1), b3 + hstepB, voffB); PG8_STAGE(PG8_SA(1, 0), a3, voffA);
            PG8_WAIT_V(8); PG8_WAIT_L(0); PG8_BAR; PG8_MMA(1, 0, At, B0); PG8_MMA(1, 1, At, B1); PG8_BAR; PG8_SCHED;
            } else {
            PG8_LDB(B0, 0, 0); PG8_SCHED; PG8_LDA(At, 0, 0); PG8_STAGE(PG8_SA(1, 1), a1 + hstepA, voffA);
            PG8_WAIT_L(8); PG8_BAR; PG8_WAIT_L(0); PG8_MMA(0, 0, At, B0); PG8_BAR; PG8_SCHED;
            PG8_LDB(B1, 0, 1); PG8_STAGE(PG8_SB(0, 0), b2, voffB);
            PG8_BAR; PG8_WAIT_L(0); PG8_MMA(0, 1, At, B1); PG8_BAR;
            PG8_LDA(At, 0, 1); PG8_STAGE(PG8_SA(0, 0), a2, voffA);
            PG8_BAR; PG8_WAIT_L(0); PG8_MMA(1, 0, At, B0); PG8_BAR; PG8_SCHED;
            PG8_STAGE(PG8_SB(0, 1), b2 + hstepB, voffB);
            PG8_WAIT_V(6); PG8_BAR; PG8_MMA(1, 1, At, B1); PG8_BAR;
            PG8_LDB(B0, 1, 0); PG8_SCHED; PG8_LDA(At, 1, 0); PG8_STAGE(PG8_SA(0, 1), a2 + hstepA, voffA);
            PG8_WAIT_L(8); PG8_BAR; PG8_WAIT_L(0); PG8_MMA(0, 0, At, B0); PG8_BAR; PG8_SCHED;
            PG8_LDB(B1, 1, 1); PG8_STAGE(PG8_SB(1, 0), b3, voffB);
            PG8_BAR; PG8_WAIT_L(0); PG8_MMA(0, 1, At, B1); PG8_BAR;
            PG8_LDA(At, 1, 1); PG8_STAGE(PG8_SA(1, 0), a3, voffA);
            PG8_BAR; PG8_WAIT_L(0); PG8_MMA(1, 0, At, B0); PG8_BAR; PG8_SCHED;
            PG8_STAGE(PG8_SB(1, 1), b3 + hstepB, voffB);
            PG8_WAIT_V(6); PG8_BAR; PG8_MMA(1, 1, At, B1); PG8_BAR;
            }
        }
        if constexpr (ALIGN_EPI) { if (wr == 0) PG8_BAR; }
        if constexpr (!Epi::AFTER_DRAIN) { E(acc, cur, wr, wc, fr, fq); S.done(cur); }
        if (!has_next) break;
#pragma unroll
        for (int a = 0; a < 2; ++a)
#pragma unroll
            for (int b = 0; b < 2; ++b)
#pragma unroll
                for (int m = 0; m < MT; ++m)
#pragma unroll
                    for (int n = 0; n < 2; ++n) acc[a][b][m][n] = (f32x4){0.f, 0.f, 0.f, 0.f};
        cur = nxt; cA = nA; cB = nB; ++ui;
        if constexpr (ALIGN_EPI) { if (wr == 1) PG8_BAR; }
    }
    PG8_WAIT_V(0);
    if constexpr (!ALIGN_EPI) { if (wr == 0) PG8_BAR; }
    PG8_BAR;
    if constexpr (Epi::AFTER_DRAIN) { E.fused(acc, cur, wr, wc, fr, fq, lds, wid, lane); S.done(cur); }
#undef PG8_SA
#undef PG8_SB
#undef PG8_STAGE
#undef PG8_LDA
#undef PG8_LDB
#undef PG8_MMA
#undef PG8_WAIT_V
#undef PG8_WAIT_L
#undef PG8_BAR
#undef PG8_SCHED
}
}

constexpr int NWAVES = 8;
constexpr int M = 18432, MP = 16384, MS = 2048, D = 2048, FF = 5632, NH = 16, HD = 128, PLE = 256;
constexpr int SEQ = 4096, DSEQ = 64, DB = 32, NG = 128, NP = 64, CROWS = 512, SROWS = 576;
#ifndef MK_ONE_LAUNCH
#define MK_ONE_LAUNCH 1
#endif
constexpr int N_PHASES = 24;
#ifndef WD_BLOCKED
#define WD_BLOCKED 0
#endif
#ifndef ACT_BLOCKED
#define ACT_BLOCKED 1
#endif
#ifndef MT_DOWN
#define MT_DOWN 3
#endif
#ifndef WGM_UP
#define WGM_UP 8
#endif
#ifndef SP2_UP
#define SP2_UP true
#endif
#ifndef WGM_N2048
#define WGM_N2048 8
#endif
#ifndef ALIGN_RES
#define ALIGN_RES false
#endif
#ifndef MT_UP
#define MT_UP 4
#endif
#ifndef MT_N2048
#define MT_N2048 3
#endif
#ifndef WGM_N4096
#define WGM_N4096 4
#endif
#ifndef MT_N4096
#define MT_N4096 4
#endif
constexpr size_t MiB = 1u << 20;
#ifndef KPAD
#define KPAD 64
#endif
constexpr int LDH = D + KPAD, LDACT = FF + KPAD, LDPB = PLE + KPAD;
constexpr size_t WS_CTL = 0, CTL_ZERO_BYTES = 1 * MiB;
constexpr size_t WS_SSQ = 256 * 1024;
constexpr size_t WS_WL = 2 * MiB, WL_STRIDE = 149 * MiB;
constexpr size_t WL_1GU = 0, WL_1D = 46 * MiB, WL_2GU = 69 * MiB, WL_2D = 115 * MiB, WL_PG = 138 * MiB, WL_PP = 147 * MiB;
constexpr size_t WS_WGLU = 300 * MiB, WS_WKV = 317 * MiB, WS_WQ = 334 * MiB, WS_WO = 343 * MiB;
constexpr size_t WS_HB = 352 * MiB;
constexpr size_t WS_ACT = 427 * MiB;
constexpr size_t WS_PROJ = 628 * MiB;
constexpr size_t WS_KP = 700 * MiB, WS_VP = 764 * MiB;
constexpr size_t WS_KS = 828 * MiB, WS_VS = 900 * MiB;
constexpr size_t WS_PB = 972 * MiB;
constexpr size_t WS_S5L = 1011 * MiB;
constexpr size_t WS_S5B = 1012 * MiB;
constexpr size_t WS_TAB = 1013 * MiB;
constexpr size_t WS_HB2 = 1014 * MiB;
constexpr size_t WS_END = 1089 * MiB;
static_assert((size_t)M * LDH * 2 <= 75 * MiB && (size_t)M * LDACT * 2 <= 201 * MiB && (size_t)2 * FF * LDH * 2 <= 46 * MiB && (size_t)D * LDACT * 2 <= 23 * MiB && (size_t)D * LDH * 2 <= 9 * MiB && (size_t)D * LDPB * 2 <= 2 * MiB && (size_t)2 * M * LDPB * 2 <= 23 * MiB && (size_t)2 * D * LDH * 2 <= 17 * MiB, "d_ws map");
constexpr int CW_BAR = 4096;
constexpr int RING_BYTES = 131072, XCH_OFF = 131072, XCH_BYTES = 8192, MISC_OFF = XCH_OFF + XCH_BYTES, LDS_BYTES = 147456;

#define GAS __attribute__((address_space(1)))
#define LAS __attribute__((address_space(3)))
typedef unsigned short bf16;
typedef unsigned v4u __attribute__((ext_vector_type(4)));
typedef unsigned v2u __attribute__((ext_vector_type(2)));
typedef float f32x4 __attribute__((ext_vector_type(4)));
typedef float f32x16 __attribute__((ext_vector_type(16)));
typedef short bf16x8 __attribute__((ext_vector_type(8)));
typedef short s16x4 __attribute__((ext_vector_type(4)));
typedef GAS unsigned gu32;
#define RLX_AGENT __ATOMIC_RELAXED, __HIP_MEMORY_SCOPE_AGENT
#define LDS_WAIT() asm volatile("s_waitcnt lgkmcnt(0)" ::: "memory")
#define VM_WAIT() asm volatile("s_waitcnt vmcnt(0)" ::: "memory")
__device__ __forceinline__ unsigned pk2(float lo, float hi) { return pg8::cvt_pk_bf16(lo, hi); }
__device__ __forceinline__ float bf2f(unsigned short b) { return __uint_as_float(((unsigned)b) << 16); }
#define XB_TMO      128
#define XB_XCNT(j)  (256  + 64 * (j))
#define XB_XSUB(j)  (1280 + 64 * (j))
#define XB_XGEN(j)  (2304 + 64 * (j))
#define XB_TOP      3328
#define XB_TOPGEN   3392
#define XCD_BAR_WORDS 3456
#define XB_SPIN_CAP (1u << 18)

__device__ __forceinline__ unsigned xb_ld(unsigned* p)              { return __hip_atomic_load(p, __ATOMIC_RELAXED, __HIP_MEMORY_SCOPE_AGENT); }
__device__ __forceinline__ unsigned xb_add(unsigned* p, unsigned v) { return __hip_atomic_fetch_add(p, v, __ATOMIC_RELAXED, __HIP_MEMORY_SCOPE_AGENT); }
__device__ __forceinline__ unsigned xb_xcc_id() { return (unsigned)__builtin_amdgcn_s_getreg((3 << 11) | 20) & 0xFu; }
#define XB_SPIN(cond, bar) do { unsigned _sp = 0; while (cond) { __builtin_amdgcn_s_sleep(1); \
    if ((++_sp & 255u) == 0u) { if (xb_ld(&(bar)[XB_TMO])) break; if (_sp > XB_SPIN_CAP) { atomicAdd(&(bar)[XB_TMO], 1u); break; } } } } while (0)

struct XcdBarrier {
    unsigned* bar; unsigned x;
    volatile LAS unsigned* st;
};

__device__ __forceinline__ XcdBarrier xcd_barrier_post(unsigned* bar, volatile LAS unsigned* st) {
    XcdBarrier b; b.bar = bar; b.x = xb_xcc_id(); b.st = st;
    if (threadIdx.x == 0) (void)xb_add(&bar[XB_XCNT(b.x)], 1u);
    return b;
}
__device__ __forceinline__ void xcd_barrier_complete(unsigned* bar, unsigned x, unsigned& nloc, unsigned& nx) {
    const unsigned G = gridDim.x * gridDim.y * gridDim.z;
    unsigned sum, cnt, mine, sp = 0u;
    for (;;) {
        sum = 0u; cnt = 0u; mine = 0u;
#pragma unroll
        for (unsigned j = 0; j < 16; ++j) { const unsigned c = xb_ld(&bar[XB_XCNT(j)]); sum += c; cnt += (c > 0u) ? 1u : 0u; mine = (j == x) ? c : mine; }
        if (sum == G) break;
        __builtin_amdgcn_s_sleep(1);
        if ((++sp & 255u) == 0u) { if (xb_ld(&bar[XB_TMO])) break; if (sp > XB_SPIN_CAP) { atomicAdd(&bar[XB_TMO], 1u); break; } }
    }
    nloc = mine > 0u ? mine : 1u; nx = cnt > 0u ? cnt : 1u;
}

__device__ __forceinline__ void xcd_barrier(const XcdBarrier& b) {
    asm volatile("s_waitcnt vmcnt(0)" ::: "memory");
    __syncthreads();
    if (threadIdx.x == 0) {
        unsigned* bar = b.bar;
        __builtin_amdgcn_s_waitcnt(0);
        unsigned nloc = b.st[0], nx = b.st[1];
        if (nloc == 0u) { xcd_barrier_complete(bar, b.x, nloc, nx); b.st[0] = nloc; b.st[1] = nx; }
        const unsigned old = xb_add(&bar[XB_XSUB(b.x)], 1u);
        const unsigned gen = old / nloc;
        if (old + 1u == (gen + 1u) * nloc) {
            __builtin_amdgcn_fence(__ATOMIC_RELEASE, "agent");
            asm volatile("s_waitcnt vmcnt(0)" ::: "memory");
            const unsigned og = xb_add(&bar[XB_TOP], 1u);
            const unsigned tg = og / nx;
            if (og + 1u == (tg + 1u) * nx) xb_add(&bar[XB_TOPGEN], 1u);
            else XB_SPIN(xb_ld(&bar[XB_TOPGEN]) == tg, bar);
            __builtin_amdgcn_fence(__ATOMIC_ACQUIRE, "agent");
            xb_add(&bar[XB_XGEN(b.x)], 1u);
            asm volatile("s_waitcnt vmcnt(0)" ::: "memory");
        } else {
            XB_SPIN(xb_ld(&bar[XB_XGEN(b.x)]) == gen, bar);
            __builtin_amdgcn_fence(__ATOMIC_ACQUIRE, "agent");
            asm volatile("s_waitcnt vmcnt(0)" ::: "memory");
        }
    }
    __syncthreads();
}

struct Args { const float* in[38]; float* out; unsigned char* ws; int ph_lo, ph_hi; };
enum { I_XP = 0, I_XS, I_SRE, I_SIM, I_CK, I_CV, I_PP, I_PS, I_F1G, I_F1WG, I_F1WU, I_F1WD, I_F2G, I_F2WG, I_F2WU, I_F2WD, I_MIXG, I_LRE, I_LIM, I_LDT, I_BRE, I_BIM, I_CRE, I_CIM, I_SD, I_GLA, I_GLB,
       I_KVG, I_WK, I_WV, I_KNG, I_WQ, I_QNG, I_RB, I_WO, I_PLG, I_PLWG, I_PLWP };
constexpr size_t O_YP = 0, O_YS = 33554432, O_PSRE = 37748736, O_PSIM = O_PSRE + 32768, O_PK = O_PSIM + 32768, O_PV = O_PK + 4194304, O_SSRE = O_PV + 4194304, O_SSIM = O_SSRE + 262144,
                 O_SK = O_SSIM + 262144, O_SV = O_SK + 4194304, O_END = O_SV + 4194304;
static_assert(O_END == 55115776, "output size");

__device__ __forceinline__ float wave_sum(float v) {
#pragma unroll
    for (int o = 1; o < 64; o <<= 1) v += __shfl_xor(v, o);
    return v;
}
struct TrRegs { float v[32]; };
__device__ __forceinline__ void tr_load(TrRegs& r, const float* W, int N, const float* gain, int item, int lane) {
    const int nblk = N / 32, kb = item / nblk, nb = item % nblk, k0 = 64 * kb, n0 = 32 * nb;
    const float* p = W + (size_t)(k0 + (lane >> 5)) * N + n0 + (lane & 31);
#pragma unroll
    for (int i = 0; i < 32; ++i) r.v[i] = p[(size_t)(2 * i) * N];
    if (gain) {
#pragma unroll
        for (int i = 0; i < 32; ++i) r.v[i] *= gain[k0 + 2 * i + (lane >> 5)];
    }
}
__device__ __forceinline__ void tr_store(const TrRegs& r, int K, int N, bf16* WT, int ldk, int blk, int row_off, LAS float* scr, int item, int lane) {
    const int nblk = N / 32, kb = item / nblk, nb = item % nblk, k0 = 64 * kb, n0 = 32 * nb;
#pragma unroll
    for (int i = 0; i < 32; ++i) scr[(2 * i + (lane >> 5)) * 33 + (lane & 31)] = r.v[i];
    LDS_WAIT(); asm volatile("" ::: "memory");
    const int c = lane & 7;
#pragma unroll
    for (int j = 0; j < 4; ++j) { const int n = (lane >> 3) + 8 * j; const LAS float* s = scr + (8 * c) * 33 + n;
        v4u o; o.x = pk2(s[0 * 33], s[1 * 33]); o.y = pk2(s[2 * 33], s[3 * 33]); o.z = pk2(s[4 * 33], s[5 * 33]); o.w = pk2(s[6 * 33], s[7 * 33]);
        const int nn = n0 + n, drow = (nn >> 7) * blk + (nn & 127) + row_off;
        if (ldk) *(GAS v4u*)(WT + (size_t)drow * ldk + k0 + 8 * c) = o;
        else *(GAS v4u*)((char*)WT + (size_t)(drow >> 8) * ((size_t)(K / 64) * 32768) + (size_t)(k0 >> 6) * 32768 + (drow & 255) * 128 + 16 * c) = o; }
    LDS_WAIT(); asm volatile("" ::: "memory");
}
__device__ __forceinline__ void tr_matrix(const float* W, int K, int N, const float* gain, bf16* WT, int blk, int row_off, LAS float* scr, int gw, int NGW, int lane, int& base, bool blocked = false) {
    const int ldk = blocked ? 0 : K + KPAD;
    const int items = (K / 64) * (N / 32);
    int st = (gw - (base % NGW)); if (st < 0) st += NGW;
    base += items;
    if (st >= items) return;
    TrRegs cur, nxt;
    tr_load(cur, W, N, gain, st, lane);
    for (int it = st; it < items; it += NGW) {
        const bool more = it + NGW < items;
        if (more) tr_load(nxt, W, N, gain, it + NGW, lane);
        tr_store(cur, K, N, WT, ldk, blk, row_off, scr, it, lane);
        if (more) {
#pragma unroll
            for (int i = 0; i < 32; ++i) cur.v[i] = nxt.v[i];
        }
    }
}
__device__ __forceinline__ float row2048_to_bf16(const float* src, bf16* dst, int lane) {
    const GAS f32x4* xr = (const GAS f32x4*)src + lane; GAS v2u* o8 = (GAS v2u*)dst + lane; float s = 0.f;
    f32x4 v[8];
#pragma unroll
    for (int j = 0; j < 8; ++j) v[j] = xr[64 * j];
#pragma unroll
    for (int j = 0; j < 8; ++j) { s += (v[j][0] * v[j][0] + v[j][1] * v[j][1]) + (v[j][2] * v[j][2] + v[j][3] * v[j][3]); v2u w; w.x = pk2(v[j][0], v[j][1]); w.y = pk2(v[j][2], v[j][3]); o8[64 * j] = w; }
    return s;
}


__device__ __forceinline__ pg8::RangeOrder proj_tail(int G, int bx, int part) {
    constexpr int NN = D / 256, P = (M / (64 * MT_N2048)) * NN, NWG_UP = (M / (64 * MT_UP)) * (2 * FF / 256);
    pg8::RangeOrder S; S.nN = NN; S.first = 0; S.count = 0;
    const int rem = NWG_UP % G, ns = G - rem, a = 3 * ns, R = P - a, n2 = R - ns;
    if (rem == 0 || R < 0 || n2 < 0 || n2 > ns) { if (part == 0) { const int per = (P + G - 1) / G; S.first = bx * per; S.count = P - S.first < per ? P - S.first : per; if (S.count < 0) S.count = 0; } return S; }
    const int c = bx - rem;
    if (c < 0) return S;
    if (part == 0) { S.first = 3 * c; S.count = 3; }
    else { S.count = c < n2 ? 2 : 1; S.first = a + (c < n2 ? 2 * c : 2 * n2 + (c - n2)); }
    return S;
}

__device__ __forceinline__ float gelu_tanh(float x) {
    const float a = 0.7978845608028654f * (x + 0.044715f * x * x * x);
    return x * __builtin_amdgcn_rcpf(1.0f + __builtin_amdgcn_exp2f(-2.885390081777927f * a));
}
__device__ __forceinline__ void s5_stage_u(const float* h, const float* ssq, const float* gm, int row0, int g, LAS float* ut, int lane) {
    const int row = row0 + lane;
    const float rs = rsqrtf(ssq[row] * (1.0f / 2048.0f) + 1e-6f);
    const f32x4* hp = (const f32x4*)(h + (size_t)row * D + 16 * g); const f32x4* gp = (const f32x4*)(gm + 16 * g);
#pragma unroll
    for (int k = 0; k < 4; ++k) { const f32x4 v = hp[k] * rs * gp[k]; *(LAS f32x4*)(ut + lane * 16 + 4 * k) = v; }
    LDS_WAIT(); asm volatile("" ::: "memory");
}

__device__ __forceinline__ void s5_prefix(const f32x4* lamtab, float2* E, int gw, int NGW, int lane) {
    float2* HIN = E + (size_t)4 * 64 * NG * NP;
    for (int it = gw; it < 4 * NG; it += NGW) {
        const int g = it & 127, b = it >> 7;
        const f32x4 lam = lamtab[g * 64 + lane];
        const size_t base = ((size_t)b * 64 * 128 + g) * 64 + lane;
        float2 e[63];
#pragma unroll
        for (int c = 0; c < 63; ++c) e[c] = E[base + (size_t)c * 128 * 64];
        float hr = 0.f, hi = 0.f;
        HIN[base] = make_float2(0.f, 0.f);
#pragma unroll
        for (int c = 0; c < 63; ++c) { const float t = lam[2] * hr - lam[3] * hi + e[c].x; hi = lam[2] * hi + lam[3] * hr + e[c].y; hr = t; HIN[base + (size_t)(c + 1) * 128 * 64] = make_float2(hr, hi); }
    }
}
constexpr int S5_HS = 16 * 272;
constexpr int S5_WAVE_LDS = 2 * S5_HS + 2048 + 1024;
template <bool WITH_Y>
__device__ __forceinline__ void s5_mfma(const bf16* h, const float* ssq, const float* gm, const f32x4* lamtab, const float* bbar, const float* cre_g, const float* cim_g, const float* dsk, float2* E,
                                        const float* sre, const float* sim, bf16* zb, float* o_pre, float* o_pim, float* o_sre, float* o_sim, LAS char* wl, int gw, int NGW, int lane, bool emode) {
    const int col = lane & 31, hh = lane >> 5;
    const int NIT = (WITH_Y && !emode) ? (2 * 64 * NG + 16 * NG) : (2 * 64 * NG);
    LAS float* ut = (LAS float*)(wl + 2 * S5_HS); LAS unsigned short* zt = (LAS unsigned short*)(wl + 2 * S5_HS + 2048);
    for (int it = gw; it < NIT; it += NGW) {
        const bool samp = it >= 2 * 64 * NG;
        int g, c, b0;
        if (!samp) { g = it & 127; c = (it >> 7) & 63; b0 = 2 * (it >> 13); } else { const int i2 = it - 2 * 64 * NG; g = i2 & 127; c = 0; b0 = 2 * (i2 >> 7); }
        const int rowbase0 = samp ? MP + b0 * DSEQ : b0 * SEQ + c * 64;
        const int seqstride = samp ? DSEQ : SEQ;
        f32x4 lamA = lamtab[g * 64 + col], lamB = lamtab[g * 64 + col + 32];
        bf16x8 bhi[4], blo[4];
#pragma unroll
        for (int cb = 0; cb < 4; ++cb) { const float* bp = bbar + (size_t)(g * 64 + col + 32 * (cb & 1)) * 32 + 16 * (cb >> 1) + 8 * hh;
            const f32x4 x0 = *(const f32x4*)bp, x1 = *(const f32x4*)(bp + 4); float xv[8] = {x0[0], x0[1], x0[2], x0[3], x1[0], x1[1], x1[2], x1[3]}; unsigned hw[4], lw[4];
#pragma unroll
            for (int j = 0; j < 4; ++j) { const unsigned hp = pk2(xv[2 * j], xv[2 * j + 1]); hw[j] = hp; lw[j] = pk2(xv[2 * j] - __uint_as_float(hp << 16), xv[2 * j + 1] - __uint_as_float(hp & 0xffff0000u)); }
            v4u a; a.x = hw[0]; a.y = hw[1]; a.z = hw[2]; a.w = hw[3]; bhi[cb] = __builtin_bit_cast(bf16x8, a); a.x = lw[0]; a.y = lw[1]; a.z = lw[2]; a.w = lw[3]; blo[cb] = __builtin_bit_cast(bf16x8, a); }
        const f32x4 gm0 = *(const f32x4*)(gm + 16 * g + 8 * hh), gm1 = *(const f32x4*)(gm + 16 * g + 8 * hh + 4);
        bf16x8 cf[4]; float dch = 0.f;
        if (WITH_Y) {
            const int cc = lane & 15, kg = lane >> 4;
#pragma unroll
            for (int s = 0; s < 4; ++s) { const int p0 = 8 * s + 2 * kg;
                const float* cr = cre_g + (size_t)(g * 16 + cc) * 64 + p0; const float* ci = cim_g + (size_t)(g * 16 + cc) * 64 + p0;
                v4u a; a.x = pk2(cr[0], -ci[0]); a.y = pk2(cr[32], -ci[32]); a.z = pk2(cr[1], -ci[1]); a.w = pk2(cr[33], -ci[33]); cf[s] = __builtin_bit_cast(bf16x8, a); }
            dch = dsk[16 * g + cc];
        }
        float hAr = 0.f, hAi = 0.f, hBr = 0.f, hBi = 0.f;
        if (WITH_Y && !emode) {
            if (!samp) { { const float2* hin = E + (size_t)4 * 64 * NG * NP + (((size_t)(b0 + hh) * 64 + c) * 128 + g) * 64;
                    const float2 ea = hin[col], ec = hin[col + 32]; hAr = ea.x; hAi = ea.y; hBr = ec.x; hBi = ec.y; } }
            else { const size_t sb = (size_t)((b0 + hh) * NG + g) * 64; hAr = sre[sb + col]; hAi = sim[sb + col]; hBr = sre[sb + col + 32]; hBi = sim[sb + col + 32]; }
        }
        const int aseq = (col >> 2) & 1, atok = (col & 3) + 4 * (col >> 3);
        {
        const int rb0 = rowbase0; const bool doy = WITH_Y && !emode;
        for (int blk = 0; blk < 4; ++blk) {
            const int arow = rb0 + aseq * seqstride + 16 * blk + atok;
            const float rs = rsqrtf(ssq[arow] * (1.0f / 2048.0f) + 1e-6f);
            const v4u hraw = *(const GAS v4u*)(h + (size_t)arow * LDH + 16 * g + 8 * hh);
            f32x4 h0, h1; h0[0] = __uint_as_float(hraw.x << 16); h0[1] = __uint_as_float(hraw.x & 0xffff0000u); h0[2] = __uint_as_float(hraw.y << 16); h0[3] = __uint_as_float(hraw.y & 0xffff0000u);
            h1[0] = __uint_as_float(hraw.z << 16); h1[1] = __uint_as_float(hraw.z & 0xffff0000u); h1[2] = __uint_as_float(hraw.w << 16); h1[3] = __uint_as_float(hraw.w & 0xffff0000u);
            const f32x4 u0 = h0 * rs * gm0, u1 = h1 * rs * gm1;
            bf16x8 ahi, alo;
            { float xv[8] = {u0[0], u0[1], u0[2], u0[3], u1[0], u1[1], u1[2], u1[3]}; unsigned hw[4], lw[4];
#pragma unroll
              for (int j = 0; j < 4; ++j) { const unsigned hp = pk2(xv[2 * j], xv[2 * j + 1]); hw[j] = hp; lw[j] = pk2(xv[2 * j] - __uint_as_float(hp << 16), xv[2 * j + 1] - __uint_as_float(hp & 0xffff0000u)); }
              v4u a; a.x = hw[0]; a.y = hw[1]; a.z = hw[2]; a.w = hw[3]; ahi = __builtin_bit_cast(bf16x8, a); a.x = lw[0]; a.y = lw[1]; a.z = lw[2]; a.w = lw[3]; alo = __builtin_bit_cast(bf16x8, a); }
            if (WITH_Y && doy) { LAS f32x4* up = (LAS f32x4*)(ut + (aseq * 16 + atok) * 16 + 8 * hh); up[0] = u0; up[1] = u1; }
            f32x16 bu[4];
#pragma unroll
            for (int cb = 0; cb < 4; ++cb) {
#pragma unroll
                for (int i = 0; i < 16; ++i) bu[cb][i] = 0.f;
                bu[cb] = __builtin_amdgcn_mfma_f32_32x32x16_bf16(alo, bhi[cb], bu[cb], 0, 0, 0);
                bu[cb] = __builtin_amdgcn_mfma_f32_32x32x16_bf16(ahi, blo[cb], bu[cb], 0, 0, 0);
                bu[cb] = __builtin_amdgcn_mfma_f32_32x32x16_bf16(ahi, bhi[cb], bu[cb], 0, 0, 0);
            }
#pragma unroll
            for (int i = 0; i < 16; ++i) {
                float t = lamA[0] * hAr - lamA[1] * hAi + bu[0][i]; hAi = lamA[0] * hAi + lamA[1] * hAr + bu[2][i]; hAr = t;
                t = lamB[0] * hBr - lamB[1] * hBi + bu[1][i]; hBi = lamB[0] * hBi + lamB[1] * hBr + bu[3][i]; hBr = t;
                if (WITH_Y && doy) { v2u w; w.x = pk2(hAr, hAi); w.y = pk2(hBr, hBi); *(LAS s16x4*)(wl + hh * S5_HS + i * 272 + col * 8) = __builtin_bit_cast(s16x4, w); }
            }
            if (WITH_Y && doy) {
                asm volatile("" ::: "memory");
                const int cc = lane & 15, kg = lane >> 4;
#pragma unroll
                for (int sq = 0; sq < 2; ++sq) {
                    f32x4 y = {0.f, 0.f, 0.f, 0.f};
#pragma unroll
                    for (int s = 0; s < 4; ++s) { const bf16x8 af = *(const LAS bf16x8*)(wl + sq * S5_HS + cc * 272 + 64 * s + 16 * kg);
                        y = __builtin_amdgcn_mfma_f32_16x16x32_bf16(af, cf[s], y, 0, 0, 0); }
#pragma unroll
                    for (int r = 0; r < 4; ++r) { const float uu = ut[(sq * 16 + 4 * kg + r) * 16 + cc]; const float z = gelu_tanh(y[r] + dch * uu);
                        zt[(sq * 16 + 4 * kg + r) * 16 + cc] = (unsigned short)(pk2(z, 0.f) & 0xffffu); }
                }
                asm volatile("" ::: "memory");
                if (lane < 32) { const int sq = lane >> 4, tok = lane & 15;
                    const bf16x8 z0 = *(const LAS bf16x8*)(zt + lane * 16), z1 = *(const LAS bf16x8*)(zt + lane * 16 + 8);
                    GAS bf16x8* zp = (GAS bf16x8*)(zb + (size_t)(rb0 + sq * seqstride + 16 * blk + tok) * LDH + 16 * g); zp[0] = z0; zp[1] = z1; }
            }
            asm volatile("" ::: "memory");
        }
        }
        if (!WITH_Y || emode) { const size_t eb = (((size_t)(b0 + hh) * 64 + c) * 128 + g) * 64; E[eb + col] = make_float2(hAr, hAi); E[eb + col + 32] = make_float2(hBr, hBi); }
        else if (samp || c == 63) { float* ore = samp ? o_sre : o_pre; float* oim = samp ? o_sim : o_pim; const size_t sb = (size_t)((b0 + hh) * NG + g) * 64;
            ore[sb + col] = hAr; oim[sb + col] = hAi; ore[sb + col + 32] = hBr; oim[sb + col + 32] = hBi; }
    }
}

namespace att {
typedef short v4i16_t __attribute__((ext_vector_type(4)));
constexpr int KBUF = 16384;
constexpr int K_OFF = 0, V_OFF = 2 * KBUF, TAB_OFF = 4 * KBUF, Q_OFF = TAB_OFF + 2560, ATT_LDS = Q_OFF + 8 * 8192;
__device__ __forceinline__ unsigned off_b(unsigned row, unsigned ch) { return 256u * row + 16u * (ch ^ (((row & 3) << 2) | ((row >> 2) & 3))); }
__device__ __forceinline__ s16x4 vtr(const LAS char* p) { return __builtin_bit_cast(s16x4, __builtin_amdgcn_ds_read_tr16_b64_v4i16((LAS v4i16_t*)p)); }
__device__ __forceinline__ int crow(int r, int hi) { return (r & 3) + 8 * (r >> 2) + 4 * hi; }
__device__ __forceinline__ void attn_unit(LAS char* lds, const bf16* Q, size_t qrow0, const bf16* Kseq, const bf16* Vseq, int hh, int cq0, int nqc, const float* tabg, bf16* O, int tid) {
    const int lane = tid & 63, w = __builtin_amdgcn_readfirstlane(tid >> 6), r = lane & 31, h = lane >> 5;
    const int wq = w >> 1; const bool active = wq < nqc; const int cq = cq0 + (active ? wq : 0);
    LAS float* tab = (LAS float*)(lds + TAB_OFF);
    for (int i = tid; i < 640; i += 512) tab[i] = tabg[i];
    const size_t qrow = qrow0 + (size_t)(active ? wq : 0) * 64 + (w & 1) * 32 + r;
    LAS char* qpark = lds + Q_OFF + w * 8192 + lane * 16;
#pragma unroll
    for (int s = 0; s < 8; ++s) *(LAS bf16x8*)(qpark + 1024 * s) = *(const bf16x8*)(Q + qrow * LDH + hh * HD + 16 * s + 8 * h);
    const int kc_lo = (cq0 - 8 > 0) ? cq0 - 8 : 0, kc_hi = cq0 + nqc - 1;
    const int srow0 = tid >> 4, sch = tid & 15;
    v4u kreg[2], vreg[2];
#define ATT_GLOAD(kc) do { _Pragma("unroll") for (int i = 0; i < 2; ++i) { const size_t go = ((size_t)(kc) * 64 + srow0 + 32 * i) * D + hh * HD + sch * 8; kreg[i] = *(const GAS v4u*)(Kseq + go); vreg[i] = *(const GAS v4u*)(Vseq + go); } } while (0)
#define ATT_LSTORE(buf) do { _Pragma("unroll") for (int i = 0; i < 2; ++i) { const unsigned o = off_b(srow0 + 32 * i, sch); *(LAS v4u*)(lds + K_OFF + (buf) * KBUF + o) = kreg[i]; *(LAS v4u*)(lds + V_OFF + (buf) * KBUF + o) = vreg[i]; } } while (0)
    ATT_GLOAD(kc_lo); ATT_LSTORE(0);
    __syncthreads();
    f32x16 o[4];
#pragma unroll
    for (int c = 0; c < 4; ++c)
#pragma unroll
        for (int i = 0; i < 16; ++i) o[c][i] = 0.f;
    float mrun = -1e30f, lsum = 0.f;
    const int tq = 32 * (w & 1) + r;
    const int q4 = (lane & 15) >> 2, p4 = lane & 3, blk16 = (lane >> 4) & 1;
    for (int kc = kc_lo; kc <= kc_hi; ++kc) {
        const int cur = (kc - kc_lo) & 1;
        if (kc < kc_hi) ATT_GLOAD(kc + 1);
        if (active && kc >= cq - 8 && kc <= cq) {
            const int jrel = kc - (cq - 8);
            const LAS char* Kb = lds + K_OFF + cur * KBUF; const LAS char* Vb = lds + V_OFF + cur * KBUF;
            f32x16 p0, p1;
#pragma unroll
            for (int i = 0; i < 16; ++i) { p0[i] = 0.f; p1[i] = 0.f; }
#pragma unroll
            for (int s = 0; s < 8; ++s) {
                const bf16x8 k0 = *(const LAS bf16x8*)(Kb + off_b(r, 2 * s + h)), k1 = *(const LAS bf16x8*)(Kb + off_b(32 + r, 2 * s + h));
                const bf16x8 qs = *(const LAS bf16x8*)(qpark + 1024 * s);
                p0 = __builtin_amdgcn_mfma_f32_32x32x16_bf16(k0, qs, p0, 0, 0, 0); p1 = __builtin_amdgcn_mfma_f32_32x32x16_bf16(k1, qs, p1, 0, 0, 0);
                if ((s & 1) == 1) __builtin_amdgcn_sched_barrier(0);
            }
            const LAS float* tb = tab + (64 * jrel + 63 - tq + 4 * h);
            float mx = -1e30f;
#pragma unroll
            for (int i = 0; i < 16; ++i) { const int kr = (i & 3) + 8 * (i >> 2); p0[i] += tb[kr]; p1[i] += tb[kr + 32]; mx = fmaxf(mx, fmaxf(p0[i], p1[i])); }
            __builtin_amdgcn_sched_barrier(0);
            mx = fmaxf(mx, __shfl_xor(mx, 32));
            const float mnew = fmaxf(mrun, mx), alpha = __builtin_amdgcn_exp2f(mrun - mnew); mrun = mnew;
            float ps = 0.f;
#pragma unroll
            for (int i = 0; i < 16; ++i) { p0[i] = __builtin_amdgcn_exp2f(p0[i] - mnew); p1[i] = __builtin_amdgcn_exp2f(p1[i] - mnew); ps += p0[i] + p1[i]; }
            lsum = lsum * alpha + ps;
#pragma unroll
            for (int c = 0; c < 4; ++c)
#pragma unroll
                for (int i = 0; i < 16; ++i) o[c][i] *= alpha;
#pragma unroll
            for (int blk = 0; blk < 2; ++blk)
#pragma unroll
                for (int s2 = 0; s2 < 2; ++s2) {
                    const f32x16& pp = blk ? p1 : p0;
                    v4u pw; pw.x = pk2(pp[8 * s2], pp[8 * s2 + 1]); pw.y = pk2(pp[8 * s2 + 2], pp[8 * s2 + 3]); pw.z = pk2(pp[8 * s2 + 4], pp[8 * s2 + 5]); pw.w = pk2(pp[8 * s2 + 6], pp[8 * s2 + 7]);
                    const bf16x8 pf = __builtin_bit_cast(bf16x8, pw);
                    const int R0 = 32 * blk + 16 * s2 + 4 * h + q4;
#pragma unroll
                    for (int c = 0; c < 4; ++c) {
                        const unsigned ch = 4 * c + 2 * blk16 + (p4 >> 1);
                        const s16x4 lo = vtr(Vb + off_b(R0, ch) + 8 * (p4 & 1)), hi = vtr(Vb + off_b(R0 + 8, ch) + 8 * (p4 & 1));
                        const bf16x8 vf = __builtin_shufflevector(lo, hi, 0, 1, 2, 3, 4, 5, 6, 7);
                        o[c] = __builtin_amdgcn_mfma_f32_32x32x16_bf16(vf, pf, o[c], 0, 0, 0);
                    }
                    __builtin_amdgcn_sched_barrier(0);
                }
        }
        if (kc < kc_hi) ATT_LSTORE(cur ^ 1);
        __syncthreads();
    }
#undef ATT_GLOAD
#undef ATT_LSTORE
    if (active) {
        const float lt = lsum + __shfl_xor(lsum, 32), inv = 1.0f / lt;
        bf16* op = O + qrow * LDH + hh * HD + 4 * h;
#pragma unroll
        for (int c = 0; c < 4; ++c)
#pragma unroll
            for (int g4 = 0; g4 < 4; ++g4) { v2u wv; wv.x = pk2(o[c][4 * g4] * inv, o[c][4 * g4 + 1] * inv); wv.y = pk2(o[c][4 * g4 + 2] * inv, o[c][4 * g4 + 3] * inv); *(GAS v2u*)(op + 32 * c + 8 * g4) = wv; }
    }
}
static_assert(ATT_LDS <= 139264, "attention LDS");
}

__global__ void __launch_bounds__(NWAVES * 64, 2) mega_fwd(Args args) {
    extern __shared__ __attribute__((aligned(16))) unsigned char lds_raw[];
    LAS unsigned char* lds = (LAS unsigned char*)lds_raw;
    volatile LAS unsigned* MISC = (volatile LAS unsigned*)(lds + MISC_OFF);
    const int tid = threadIdx.x, lane = tid & 63, wave = __builtin_amdgcn_readfirstlane(tid >> 6);
    const int G = gridDim.x, bx = blockIdx.x, vcu = (G % 8 == 0) ? (bx % 8) * (G / 8) + bx / 8 : bx;
    const int gw = vcu * NWAVES + wave, NGW = G * NWAVES;
    unsigned char* ws = args.ws;
    gu32* ctl = (gu32*)(ws + WS_CTL);
    float* ssq = (float*)(ws + WS_SSQ);
    bf16* HB = (bf16*)(ws + WS_HB); bf16* HB2 = (bf16*)(ws + WS_HB2); bf16* ACT = (bf16*)(ws + WS_ACT); bf16* ZQO = (bf16*)(ws + WS_ACT); bf16* PROJ = (bf16*)(ws + WS_PROJ);
    bf16* KP = (bf16*)(ws + WS_KP); bf16* VP = (bf16*)(ws + WS_VP); bf16* KS = (bf16*)(ws + WS_KS); bf16* VS = (bf16*)(ws + WS_VS);
    bf16* PB = (bf16*)(ws + WS_PB); float2* EST = (float2*)(ws + WS_KP);   f32x4* S5L = (f32x4*)(ws + WS_S5L); float* S5B = (float*)(ws + WS_S5B); float* TAB = (float*)(ws + WS_TAB);
    float* Hres = args.out;
    for (int u = tid; u < (LDS_BYTES - MISC_OFF) / 4; u += NWAVES * 64) ((LAS unsigned*)(lds + MISC_OFF))[u] = 0u;
    __syncthreads();
#if MK_ONE_LAUNCH
    XcdBarrier bar = xcd_barrier_post((unsigned*)(ctl + CW_BAR), MISC + 8);
#define GRID_BAR() xcd_barrier(bar)
#else
#define GRID_BAR() do {} while (0)
#endif
    const int lo = args.ph_lo, hi = args.ph_hi;
#define IN(k) (lo <= (k) && (k) < hi)
#define SEAM() GRID_BAR()

    if (IN(0)) {
        LAS float* scr = (LAS float*)(lds + wave * 16384);
        int base = 0;
#pragma unroll
        for (int l = 0; l < 2; ++l) {
            unsigned char* wl = ws + WS_WL + l * WL_STRIDE;
            tr_matrix(args.in[I_F1WG] + (size_t)l * D * FF, D, FF, args.in[I_F1G] + l * D, (bf16*)(wl + WL_1GU), 256, 0, scr, gw, NGW, lane, base);
            tr_matrix(args.in[I_F1WU] + (size_t)l * D * FF, D, FF, args.in[I_F1G] + l * D, (bf16*)(wl + WL_1GU), 256, 128, scr, gw, NGW, lane, base);
            tr_matrix(args.in[I_F1WD] + (size_t)l * D * FF, FF, D, nullptr, (bf16*)(wl + WL_1D), 128, 0, scr, gw, NGW, lane, base, WD_BLOCKED);
            tr_matrix(args.in[I_F2WG] + (size_t)l * D * FF, D, FF, args.in[I_F2G] + l * D, (bf16*)(wl + WL_2GU), 256, 0, scr, gw, NGW, lane, base);
            tr_matrix(args.in[I_F2WU] + (size_t)l * D * FF, D, FF, args.in[I_F2G] + l * D, (bf16*)(wl + WL_2GU), 256, 128, scr, gw, NGW, lane, base);
            tr_matrix(args.in[I_F2WD] + (size_t)l * D * FF, FF, D, nullptr, (bf16*)(wl + WL_2D), 128, 0, scr, gw, NGW, lane, base, WD_BLOCKED);
            tr_matrix(args.in[I_PLWG] + (size_t)l * D * D, D, D, args.in[I_PLG] + l * D, (bf16*)(wl + WL_PG), 128, 0, scr, gw, NGW, lane, base);
            tr_matrix(args.in[I_PLWP] + (size_t)l * PLE * D, PLE, D, nullptr, (bf16*)(wl + WL_PP), 128, 0, scr, gw, NGW, lane, base);
        }
        tr_matrix(args.in[I_GLA], D, D, nullptr, (bf16*)(ws + WS_WGLU), 256, 0, scr, gw, NGW, lane, base);
        tr_matrix(args.in[I_GLB], D, D, nullptr, (bf16*)(ws + WS_WGLU), 256, 128, scr, gw, NGW, lane, base);
        tr_matrix(args.in[I_WK], D, D, args.in[I_KVG], (bf16*)(ws + WS_WKV), 128, 0, scr, gw, NGW, lane, base);
        tr_matrix(args.in[I_WV], D, D, args.in[I_KVG], (bf16*)(ws + WS_WKV), 128, 2048, scr, gw, NGW, lane, base);
        tr_matrix(args.in[I_WQ], D, D, args.in[I_MIXG] + D, (bf16*)(ws + WS_WQ), 128, 0, scr, gw, NGW, lane, base);
        tr_matrix(args.in[I_WO], D, D, nullptr, (bf16*)(ws + WS_WO), 128, 0, scr, gw, NGW, lane, base);
        for (int m = gw; m < M; m += NGW) { const float* src = (m < MP) ? args.in[I_XP] + (size_t)m * D : args.in[I_XS] + (size_t)(m - MP) * D;
            const float s = wave_sum(row2048_to_bf16(src, HB + (size_t)m * LDH, lane)); if (lane == 0) ssq[m] = s; }
        for (int m = gw; m < DB * CROWS; m += NGW) { const int b = m >> 9, t = m & 511;
            (void)row2048_to_bf16(args.in[I_CK] + (size_t)m * D, KS + (size_t)(b * SROWS + t) * D, lane);
            (void)row2048_to_bf16(args.in[I_CV] + (size_t)m * D, VS + (size_t)(b * SROWS + t) * D, lane); }
        for (int m = gw; m < 2 * M; m += NGW) { const int l = m / M, r = m % M;
            const float* src = (r < MP) ? args.in[I_PP] + ((size_t)l * MP + r) * PLE : args.in[I_PS] + ((size_t)l * MS + (r - MP)) * PLE;
            const f32x4 v = ((const GAS f32x4*)src)[lane]; v2u w; w.x = pk2(v[0], v[1]); w.y = pk2(v[2], v[3]); ((GAS v2u*)(PB + (size_t)m * LDPB))[lane] = w; }
        { const int i = gw * 64 + lane;
          if (i < NG * NP) { const int g = i >> 6;
            const double lre = args.in[I_LRE][i], lim = args.in[I_LIM][i], dt = exp((double)args.in[I_LDT][g]);
            const double er = exp(lre * dt), sn = sin(lim * dt), cs = cos(lim * dt), lbr = er * cs, lbi = er * sn;
            const double e128 = exp(lre * dt * 64.0), s128 = sin(lim * dt * 64.0), c128 = cos(lim * dt * 64.0);
            f32x4 lv; lv[0] = (float)lbr; lv[1] = (float)lbi; lv[2] = (float)(e128 * c128); lv[3] = (float)(e128 * s128); S5L[i] = lv;
            const double nr = lbr - 1.0, ni = lbi, den = lre * lre + lim * lim, fr = (nr * lre + ni * lim) / den, fi = (ni * lre - nr * lim) / den;
            for (int c = 0; c < 16; ++c) { const double br = args.in[I_BRE][(size_t)i * 16 + c], bi = args.in[I_BIM][(size_t)i * 16 + c];
                S5B[(size_t)i * 32 + c] = (float)(fr * br - fi * bi); S5B[(size_t)i * 32 + 16 + c] = (float)(fr * bi + fi * br); } } }
        for (int i = gw * 64 + lane; i < NH * 640; i += NGW * 64) { const int hh = i / 640, y = i % 640; int dd = 575 - y; dd = dd < -256 ? -256 : (dd > 256 ? 256 : dd);
            TAB[i] = 1.4426950408889634f * args.in[I_RB][hh * 513 + dd + 256]; }
    }
    SEAM();

    { constexpr int l = 0;

        const int pb = 1 + 10 * l;
        unsigned char* wl = ws + WS_WL + l * WL_STRIDE;
        float* sq = ssq + (size_t)(4 * l) * M;
        if (l == 1 && IN(pb + 0)) {
            pg8::Gemm g{HB2, (const bf16*)(ws + WS_WKV), M, 2 * D, D, LDH, LDH}; pg8::StaticOrder S; S.init(M, 2 * D, G, G - 1 - bx, 64 * MT_N4096, WGM_N4096);
            pg8::EpiHead<0, MT_N4096> E{sq, args.in[I_KNG], 1.0f, (PG8_LAS float*)(lds + XCH_OFF), KP, KS, VP, VS, args.out + O_PK, args.out + O_PV, args.out + O_SK, args.out + O_SV, 0};
            pg8::gemm_phase<pg8::EpiHead<0, MT_N4096>, pg8::StaticOrder, true, true, MT_N4096>(lds, g, S, E);
        }
        if (IN(pb + 1)) {
            pg8::Gemm g{l == 0 ? HB : HB2, (const bf16*)(wl + WL_1GU), M, 2 * FF, D, LDH, LDH}; pg8::StaticOrder S; S.init(M, 2 * FF, G, bx, 64 * MT_UP);
            pg8::EpiUp<MT_UP> E{ACT, sq, ACT_BLOCKED ? 0 : LDACT};
            pg8::gemm_phase<pg8::EpiUp<MT_UP>, pg8::StaticOrder, true, SP2_UP, MT_UP>(lds, g, S, E);
        }
        if (IN(pb + 2)) {
            int kple = PLE; asm volatile("" : "+s"(kple));
            pg8::Gemm g{PB + (size_t)l * M * LDPB, (const bf16*)(wl + WL_PP), M, D, kple, LDPB, LDPB}; const pg8::RangeOrder S = proj_tail(G, bx, 0);
            pg8::EpiProj<MT_N2048> E{PROJ, D};
            pg8::gemm_phase<pg8::EpiProj<MT_N2048>, pg8::RangeOrder, true, true, MT_N2048>(lds, g, S, E);
        }
        SEAM();
        if (IN(pb + 3)) {
            pg8::Gemm g{ACT, (const bf16*)(wl + WL_1D), M, D, FF, ACT_BLOCKED ? 64 : LDACT, WD_BLOCKED ? 64 : LDACT, ACT_BLOCKED ? ACT_PR * 128 : 0, WD_BLOCKED ? 32768 : 0, ACT_BLOCKED ? (long)(FF / 64) * ACT_PR * 128 : 0L, WD_BLOCKED ? (long)(FF / 64) * 32768 : 0L, ACT_BLOCKED ? ACT_PR * 32 : 0}; pg8::StaticOrder S; S.init(M, D, G, bx, 64 * MT_DOWN, WGM_N2048);
            pg8::EpiRes<0, MT_DOWN, l == 0> E{args.in[I_XP], args.in[I_XS], HB2, nullptr, HB, sq + M, nullptr, nullptr, 0.5f, LDH};
            pg8::gemm_phase<pg8::EpiRes<0, MT_DOWN, l == 0>, pg8::StaticOrder, ALIGN_RES, true, MT_DOWN>(lds, g, S, E);
        }
        SEAM();
        if (IN(pb + 4)) {
            if (l == 0) s5_mfma<true>(HB, sq + M, args.in[I_MIXG], S5L, S5B, args.in[I_CRE], args.in[I_CIM], args.in[I_SD], EST, args.in[I_SRE], args.in[I_SIM], ZQO,
                                  args.out + O_PSRE, args.out + O_PSIM, args.out + O_SSRE, args.out + O_SSIM, (LAS char*)(lds + wave * S5_WAVE_LDS), gw, NGW, lane, true);
            else { pg8::Gemm g{HB, (const bf16*)(ws + WS_WQ), M, D, D, LDH, LDH}; pg8::StaticOrder S; S.init(M, D, G, bx, 64 * MT_N2048, WGM_N2048);
                pg8::EpiHead<1, MT_N2048> E{sq + M, args.in[I_QNG], 0.08838834764831845f * 1.4426950408889634f, (PG8_LAS float*)(lds + XCH_OFF), ZQO, nullptr, nullptr, nullptr, nullptr, nullptr, nullptr, nullptr, LDH};
                pg8::gemm_phase<pg8::EpiHead<1, MT_N2048>, pg8::StaticOrder, true, true, MT_N2048>(lds, g, S, E); }
        }
        SEAM();
        if (l == 0) { if (IN(21)) s5_prefix(S5L, EST, gw, NGW, lane); SEAM(); }
        if (IN(pb + 5)) {
            if (l == 0) s5_mfma<true>(HB, sq + M, args.in[I_MIXG], S5L, S5B, args.in[I_CRE], args.in[I_CIM], args.in[I_SD], EST, args.in[I_SRE], args.in[I_SIM], ZQO,
                                  args.out + O_PSRE, args.out + O_PSIM, args.out + O_SSRE, args.out + O_SSIM, (LAS char*)(lds + wave * S5_WAVE_LDS), gw, NGW, lane, false);
            else {
                for (int ui = vcu; ui < 1024 + 512; ui += G) {
                    if (ui < 1024) { const int qb = ui & 15, hh = (ui >> 4) & 15, b = ui >> 8;
                        att::attn_unit((LAS char*)lds, ZQO, (size_t)b * SEQ + 256 * qb, KP + (size_t)b * SEQ * D, VP + (size_t)b * SEQ * D, hh, 4 * qb, 4, TAB + hh * 640, HB2, tid); }
                    else { const int u2 = ui - 1024, hh = u2 & 15, b = u2 >> 4;
                        att::attn_unit((LAS char*)lds, ZQO, (size_t)MP + b * DSEQ, KS + (size_t)b * SROWS * D, VS + (size_t)b * SROWS * D, hh, 8, 1, TAB + hh * 640, HB2, tid); }
                }
            }
        }
        SEAM();
        if (IN(pb + 6)) {
            if (l == 0) { pg8::Gemm g{ZQO, (const bf16*)(ws + WS_WGLU), M, 2 * D, D, LDH, LDH}; pg8::StaticOrder S; S.init(M, 2 * D, G, bx, 64 * MT_N4096, WGM_N4096);
                pg8::EpiRes<1, MT_N4096, false> E{nullptr, nullptr, HB, nullptr, HB, sq + 2 * M, nullptr, nullptr, 1.0f, LDH};
                pg8::gemm_phase<pg8::EpiRes<1, MT_N4096, false>, pg8::StaticOrder, ALIGN_RES, true, MT_N4096>(lds, g, S, E); }
            else { pg8::Gemm g{HB2, (const bf16*)(ws + WS_WO), M, D, D, LDH, LDH}; pg8::StaticOrder S; S.init(M, D, G, bx, 64 * MT_N2048, WGM_N2048);
                pg8::EpiRes<0, MT_N2048, false> E{nullptr, nullptr, HB, nullptr, HB, sq + 2 * M, nullptr, nullptr, 1.0f, LDH};
                pg8::gemm_phase<pg8::EpiRes<0, MT_N2048, false>, pg8::StaticOrder, ALIGN_RES, true, MT_N2048>(lds, g, S, E); }
        }
        SEAM();
        if (IN(pb + 7)) {
            pg8::Gemm g{HB, (const bf16*)(wl + WL_2GU), M, 2 * FF, D, LDH, LDH}; pg8::StaticOrder S; S.init(M, 2 * FF, G, bx, 64 * MT_UP);
            pg8::EpiUp<MT_UP> E{ACT, sq + 2 * M, ACT_BLOCKED ? 0 : LDACT};
            pg8::gemm_phase<pg8::EpiUp<MT_UP>, pg8::StaticOrder, true, SP2_UP, MT_UP>(lds, g, S, E);
        }
        if (IN(22 + l)) {
            int kple = PLE; asm volatile("" : "+s"(kple));
            pg8::Gemm g{PB + (size_t)l * M * LDPB, (const bf16*)(wl + WL_PP), M, D, kple, LDPB, LDPB}; const pg8::RangeOrder S = proj_tail(G, bx, 1);
            pg8::EpiProj<MT_N2048> E{PROJ, D};
            pg8::gemm_phase<pg8::EpiProj<MT_N2048>, pg8::RangeOrder, true, true, MT_N2048>(lds, g, S, E);
        }
        SEAM();
        if (IN(pb + 8)) {
            pg8::Gemm g{ACT, (const bf16*)(wl + WL_2D), M, D, FF, ACT_BLOCKED ? 64 : LDACT, WD_BLOCKED ? 64 : LDACT, ACT_BLOCKED ? ACT_PR * 128 : 0, WD_BLOCKED ? 32768 : 0, ACT_BLOCKED ? (long)(FF / 64) * ACT_PR * 128 : 0L, WD_BLOCKED ? (long)(FF / 64) * 32768 : 0L, ACT_BLOCKED ? ACT_PR * 32 : 0}; pg8::StaticOrder S; S.init(M, D, G, bx, 64 * MT_DOWN, WGM_N2048);
            pg8::EpiRes<0, MT_DOWN, false> E{nullptr, nullptr, HB, nullptr, HB, sq + 3 * M, nullptr, nullptr, 0.5f, LDH};
            pg8::gemm_phase<pg8::EpiRes<0, MT_DOWN, false>, pg8::StaticOrder, ALIGN_RES, true, MT_DOWN>(lds, g, S, E);
        }
        SEAM();
        if (IN(pb + 9)) {
            pg8::Gemm g{HB, (const bf16*)(wl + WL_PG), M, D, D, LDH, LDH}; pg8::StaticOrder S; S.init(M, D, G, bx, 64 * MT_N2048, WGM_N2048);
            pg8::EpiRes<2, MT_N2048, false> E{nullptr, nullptr, HB, l == 0 ? nullptr : Hres, l == 0 ? HB2 : nullptr, l == 0 ? sq + 4 * M : nullptr, sq + 3 * M, PROJ, 1.0f, LDH};
            pg8::gemm_phase<pg8::EpiRes<2, MT_N2048, false>, pg8::StaticOrder, ALIGN_RES, true, MT_N2048>(lds, g, S, E);
        }
        if (l == 0) SEAM();
        }
    { constexpr int l = 1;

        const int pb = 1 + 10 * l;
        unsigned char* wl = ws + WS_WL + l * WL_STRIDE;
        float* sq = ssq + (size_t)(4 * l) * M;
        if (l == 1 && IN(pb + 0)) {
            pg8::Gemm g{HB2, (const bf16*)(ws + WS_WKV), M, 2 * D, D, LDH, LDH}; pg8::StaticOrder S; S.init(M, 2 * D, G, G - 1 - bx, 64 * MT_N4096, WGM_N4096);
            pg8::EpiHead<0, MT_N4096> E{sq, args.in[I_KNG], 1.0f, (PG8_LAS float*)(lds + XCH_OFF), KP, KS, VP, VS, args.out + O_PK, args.out + O_PV, args.out + O_SK, args.out + O_SV, 0};
            pg8::gemm_phase<pg8::EpiHead<0, MT_N4096>, pg8::StaticOrder, true, true, MT_N4096>(lds, g, S, E);
        }
        if (IN(pb + 1)) {
            pg8::Gemm g{l == 0 ? HB : HB2, (const bf16*)(wl + WL_1GU), M, 2 * FF, D, LDH, LDH}; pg8::StaticOrder S; S.init(M, 2 * FF, G, bx, 64 * MT_UP);
            pg8::EpiUp<MT_UP> E{ACT, sq, ACT_BLOCKED ? 0 : LDACT};
            pg8::gemm_phase<pg8::EpiUp<MT_UP>, pg8::StaticOrder, true, SP2_UP, MT_UP>(lds, g, S, E);
        }
        if (IN(pb + 2)) {
            int kple = PLE; asm volatile("" : "+s"(kple));
            pg8::Gemm g{PB + (size_t)l * M * LDPB, (const bf16*)(wl + WL_PP), M, D, kple, LDPB, LDPB}; const pg8::RangeOrder S = proj_tail(G, bx, 0);
            pg8::EpiProj<MT_N2048> E{PROJ, D};
            pg8::gemm_phase<pg8::EpiProj<MT_N2048>, pg8::RangeOrder, true, true, MT_N2048>(lds, g, S, E);
        }
        SEAM();
        if (IN(pb + 3)) {
            pg8::Gemm g{ACT, (const bf16*)(wl + WL_1D), M, D, FF, ACT_BLOCKED ? 64 : LDACT, WD_BLOCKED ? 64 : LDACT, ACT_BLOCKED ? ACT_PR * 128 : 0, WD_BLOCKED ? 32768 : 0, ACT_BLOCKED ? (long)(FF / 64) * ACT_PR * 128 : 0L, WD_BLOCKED ? (long)(FF / 64) * 32768 : 0L, ACT_BLOCKED ? ACT_PR * 32 : 0}; pg8::StaticOrder S; S.init(M, D, G, bx, 64 * MT_DOWN, WGM_N2048);
            pg8::EpiRes<0, MT_DOWN, l == 0> E{args.in[I_XP], args.in[I_XS], HB2, nullptr, HB, sq + M, nullptr, nullptr, 0.5f, LDH};
            pg8::gemm_phase<pg8::EpiRes<0, MT_DOWN, l == 0>, pg8::StaticOrder, ALIGN_RES, true, MT_DOWN>(lds, g, S, E);
        }
        SEAM();
        if (IN(pb + 4)) {
            if (l == 0) s5_mfma<true>(HB, sq + M, args.in[I_MIXG], S5L, S5B, args.in[I_CRE], args.in[I_CIM], args.in[I_SD], EST, args.in[I_SRE], args.in[I_SIM], ZQO,
                                  args.out + O_PSRE, args.out + O_PSIM, args.out + O_SSRE, args.out + O_SSIM, (LAS char*)(lds + wave * S5_WAVE_LDS), gw, NGW, lane, true);
            else { pg8::Gemm g{HB, (const bf16*)(ws + WS_WQ), M, D, D, LDH, LDH}; pg8::StaticOrder S; S.init(M, D, G, bx, 64 * MT_N2048, WGM_N2048);
                pg8::EpiHead<1, MT_N2048> E{sq + M, args.in[I_QNG], 0.08838834764831845f * 1.4426950408889634f, (PG8_LAS float*)(lds + XCH_OFF), ZQO, nullptr, nullptr, nullptr, nullptr, nullptr, nullptr, nullptr, LDH};
                pg8::gemm_phase<pg8::EpiHead<1, MT_N2048>, pg8::StaticOrder, true, true, MT_N2048>(lds, g, S, E); }
        }
        SEAM();
        if (l == 0) { if (IN(21)) s5_prefix(S5L, EST, gw, NGW, lane); SEAM(); }
        if (IN(pb + 5)) {
            if (l == 0) s5_mfma<true>(HB, sq + M, args.in[I_MIXG], S5L, S5B, args.in[I_CRE], args.in[I_CIM], args.in[I_SD], EST, args.in[I_SRE], args.in[I_SIM], ZQO,
                                  args.out + O_PSRE, args.out + O_PSIM, args.out + O_SSRE, args.out + O_SSIM, (LAS char*)(lds + wave * S5_WAVE_LDS), gw, NGW, lane, false);
            else {
                for (int ui = vcu; ui < 1024 + 512; ui += G) {
                    if (ui < 1024) { const int qb = ui & 15, hh = (ui >> 4) & 15, b = ui >> 8;
                        att::attn_unit((LAS char*)lds, ZQO, (size_t)b * SEQ + 256 * qb, KP + (size_t)b * SEQ * D, VP + (size_t)b * SEQ * D, hh, 4 * qb, 4, TAB + hh * 640, HB2, tid); }
                    else { const int u2 = ui - 1024, hh = u2 & 15, b = u2 >> 4;
                        att::attn_unit((LAS char*)lds, ZQO, (size_t)MP + b * DSEQ, KS + (size_t)b * SROWS * D, VS + (size_t)b * SROWS * D, hh, 8, 1, TAB + hh * 640, HB2, tid); }
                }
            }
        }
        SEAM();
        if (IN(pb + 6)) {
            if (l == 0) { pg8::Gemm g{ZQO, (const bf16*)(ws + WS_WGLU), M, 2 * D, D, LDH, LDH}; pg8::StaticOrder S; S.init(M, 2 * D, G, bx, 64 * MT_N4096, WGM_N4096);
                pg8::EpiRes<1, MT_N4096, false> E{nullptr, nullptr, HB, nullptr, HB, sq + 2 * M, nullptr, nullptr, 1.0f, LDH};
                pg8::gemm_phase<pg8::EpiRes<1, MT_N4096, false>, pg8::StaticOrder, ALIGN_RES, true, MT_N4096>(lds, g, S, E); }
            else { pg8::Gemm g{HB2, (const bf16*)(ws + WS_WO), M, D, D, LDH, LDH}; pg8::StaticOrder S; S.init(M, D, G, bx, 64 * MT_N2048, WGM_N2048);
                pg8::EpiRes<0, MT_N2048, false> E{nullptr, nullptr, HB, nullptr, HB, sq + 2 * M, nullptr, nullptr, 1.0f, LDH};
                pg8::gemm_phase<pg8::EpiRes<0, MT_N2048, false>, pg8::StaticOrder, ALIGN_RES, true, MT_N2048>(lds, g, S, E); }
        }
        SEAM();
        if (IN(pb + 7)) {
            pg8::Gemm g{HB, (const bf16*)(wl + WL_2GU), M, 2 * FF, D, LDH, LDH}; pg8::StaticOrder S; S.init(M, 2 * FF, G, bx, 64 * MT_UP);
            pg8::EpiUp<MT_UP> E{ACT, sq + 2 * M, ACT_BLOCKED ? 0 : LDACT};
            pg8::gemm_phase<pg8::EpiUp<MT_UP>, pg8::StaticOrder, true, SP2_UP, MT_UP>(lds, g, S, E);
        }
        if (IN(22 + l)) {
            int kple = PLE; asm volatile("" : "+s"(kple));
            pg8::Gemm g{PB + (size_t)l * M * LDPB, (const bf16*)(wl + WL_PP), M, D, kple, LDPB, LDPB}; const pg8::RangeOrder S = proj_tail(G, bx, 1);
            pg8::EpiProj<MT_N2048> E{PROJ, D};
            pg8::gemm_phase<pg8::EpiProj<MT_N2048>, pg8::RangeOrder, true, true, MT_N2048>(lds, g, S, E);
        }
        SEAM();
        if (IN(pb + 8)) {
            pg8::Gemm g{ACT, (const bf16*)(wl + WL_2D), M, D, FF, ACT_BLOCKED ? 64 : LDACT, WD_BLOCKED ? 64 : LDACT, ACT_BLOCKED ? ACT_PR * 128 : 0, WD_BLOCKED ? 32768 : 0, ACT_BLOCKED ? (long)(FF / 64) * ACT_PR * 128 : 0L, WD_BLOCKED ? (long)(FF / 64) * 32768 : 0L, ACT_BLOCKED ? ACT_PR * 32 : 0}; pg8::StaticOrder S; S.init(M, D, G, bx, 64 * MT_DOWN, WGM_N2048);
            pg8::EpiRes<0, MT_DOWN, false> E{nullptr, nullptr, HB, nullptr, HB, sq + 3 * M, nullptr, nullptr, 0.5f, LDH};
            pg8::gemm_phase<pg8::EpiRes<0, MT_DOWN, false>, pg8::StaticOrder, ALIGN_RES, true, MT_DOWN>(lds, g, S, E);
        }
        SEAM();
        if (IN(pb + 9)) {
            pg8::Gemm g{HB, (const bf16*)(wl + WL_PG), M, D, D, LDH, LDH}; pg8::StaticOrder S; S.init(M, D, G, bx, 64 * MT_N2048, WGM_N2048);
            pg8::EpiRes<2, MT_N2048, false> E{nullptr, nullptr, HB, l == 0 ? nullptr : Hres, l == 0 ? HB2 : nullptr, l == 0 ? sq + 4 * M : nullptr, sq + 3 * M, PROJ, 1.0f, LDH};
            pg8::gemm_phase<pg8::EpiRes<2, MT_N2048, false>, pg8::StaticOrder, ALIGN_RES, true, MT_N2048>(lds, g, S, E);
        }
        if (l == 0) SEAM();
        }
#undef IN
#undef SEAM
}

extern "C" void kernel_launch(void* const* d_in, const int* in_sizes, int n_in, void* d_out, int out_size, void* d_ws, size_t ws_size, hipStream_t stream) {
    static int grid = 0;
    if (grid == 0) {
        if (n_in != 38 || out_size != (int)O_END || ws_size < WS_END) { fprintf(stderr, "kernel_launch: unexpected shapes (n_in %d, out %d, ws %zu)\n", n_in, out_size, ws_size); grid = -1; return; }
        int dev = 0, cus = 0, per_cu = 0;
        if (hipGetDevice(&dev) != hipSuccess || hipDeviceGetAttribute(&cus, hipDeviceAttributeMultiprocessorCount, dev) != hipSuccess) { grid = -1; return; }
        if (hipFuncSetAttribute((const void*)mega_fwd, hipFuncAttributeMaxDynamicSharedMemorySize, LDS_BYTES) != hipSuccess) { fprintf(stderr, "kernel_launch: hipFuncSetAttribute failed\n"); grid = -1; return; }
        if (hipOccupancyMaxActiveBlocksPerMultiprocessor(&per_cu, (const void*)mega_fwd, NWAVES * 64, LDS_BYTES) != hipSuccess || per_cu < 1) { fprintf(stderr, "kernel_launch: occupancy query says %d\n", per_cu); }
        (void)hipGetLastError();
        grid = cus;
    }
    if (grid < 0) return;
    if (hipMemsetAsync((char*)d_ws + WS_CTL, 0, CTL_ZERO_BYTES, stream) != hipSuccess) return;
    Args a{};
    for (int i = 0; i < 38; ++i) a.in[i] = (const float*)d_in[i];
    a.out = (float*)d_out; a.ws = (unsigned char*)d_ws;
#if MK_ONE_LAUNCH
    a.ph_lo = 0; a.ph_hi = N_PHASES;
    hipLaunchKernelGGL(mega_fwd, dim3(grid), dim3(NWAVES * 64), LDS_BYTES, stream, a);
#else
    static const int order[23] = {0, 2, 3, 4, 5, 21, 6, 7, 8, 22, 9, 10, 11, 12, 13, 14, 15, 16, 17, 18, 23, 19, 20};
    for (int oi = 0; oi < 23; ++oi) { const int p = order[oi]; a.ph_lo = p; a.ph_hi = p + 1; int reps = 1;
        for (int r = 0; r < reps; ++r) hipLaunchKernelGGL(mega_fwd, dim3(grid), dim3(NWAVES * 64), LDS_BYTES, stream, a); }
#endif
}
```

```cpp
#include <hip/hip_runtime.h>
#include <cstdio>
#include <cstdint>
namespace pg8 {
#define PG8_LAS __attribute__((address_space(3)))
typedef unsigned short bf16_t;
typedef short bf16x8 __attribute__((ext_vector_type(8)));
typedef float f32x4 __attribute__((ext_vector_type(4)));
typedef unsigned u32x4 __attribute__((ext_vector_type(4)));
constexpr int BM = 256, BK = 64, HALF = 128, HTB = HALF * BK * 2  , STAGE_BYTES = 8 * HTB, NXCD = 8, WGM = 8;

__host__ __device__ __forceinline__ int lds_byte(int r, int c) { const int st = (r >> 4) * 2 + (c >> 5), rr = r & 15, cc = c & 31, ob = rr * 64 + cc * 2; return st * 1024 + (ob ^ (((ob >> 9) & 1) << 5)); }
__host__ __device__ __forceinline__ void stage_rc(int b, int& R, int& C) { const int st = b / 1024, sb = b % 1024, swz = sb ^ (((sb >> 9) & 1) << 5); R = (st >> 1) * 16 + swz / 64; C = (st & 1) * 32 + (swz % 64) / 2; }
__host__ __device__ __forceinline__ int perm32(int rho) { const int n = rho >> 4, i = rho & 15; return 8 * (i >> 2) + 4 * n + (i & 3); }

struct Unit { int pm, pn; };
struct Gemm { const bf16_t* A; const bf16_t* Bt; int M, N, K, lda, ldb; int ksA = 0, ksB = 0; long tsA = 0, tsB = 0; int sbA = 0; };

struct RangeOrder {
    int first, count, nN;
    __host__ __device__ bool next(int i, Unit& u) const { if (i >= count) return false; const int id = first + i; u.pm = id / nN; u.pn = id - u.pm * nN; return true; }
    __device__ __forceinline__ void a_ready(const Unit&) const {}
    __device__ __forceinline__ void done(const Unit&) const {}
};
struct StaticOrder {
    int nM, nN, nwg, G, c, wgm;
    __host__ __device__ void init(int M, int N, int G_, int c_, int bm = BM, int wgm_ = WGM) { nM = M / bm; nN = N / BM; nwg = nM * nN; G = G_; c = c_; wgm = wgm_; }
    __host__ __device__ bool next(int i, Unit& u) const {
        const long L = (long)i * G + c; if (L >= nwg) return false;
        int wgid = (int)L; { const int q = nwg / NXCD, r = nwg % NXCD, xcd = wgid % NXCD, off = wgid / NXCD; wgid = (xcd < r ? xcd * (q + 1) : r * (q + 1) + (xcd - r) * q) + off; }
        const int nig = wgm * nN, gid = wgid / nig, fm = gid * wgm, gsz = (nM - fm) < wgm ? (nM - fm) : wgm;
        u.pm = fm + ((wgid % nig) % gsz); u.pn = (wgid % nig) / gsz; return true;
    }
    __device__ __forceinline__ void a_ready(const Unit&) const {}
    __device__ __forceinline__ void done(const Unit&) const {}
};

typedef float f32x2 __attribute__((ext_vector_type(2)));
typedef unsigned u32x2 __attribute__((ext_vector_type(2)));
typedef __bf16 bf16x2_t __attribute__((ext_vector_type(2)));
__device__ __forceinline__ unsigned cvt_pk_bf16(float lo, float hi) { f32x2 v = {lo, hi}; bf16x2_t b = __builtin_convertvector(v, bf16x2_t); return __builtin_bit_cast(unsigned, b); }
__device__ __forceinline__ float sigm(float x) { return __builtin_amdgcn_rcpf(1.0f + __builtin_amdgcn_exp2f(-1.4426950408889634f * x)); }
__device__ __forceinline__ f32x4 sigm4(f32x4 x) { f32x4 r; r[0] = sigm(x[0]); r[1] = sigm(x[1]); r[2] = sigm(x[2]); r[3] = sigm(x[3]); return r; }
constexpr int MTOK = 18432, MPROMPT = 16384, DM = 2048, FFH = 5632;
#ifndef ACT_PR
#define ACT_PR 192
#endif
constexpr float RMS_EPS = 1e-6f;

template <int MT> struct EpiUp {
    static constexpr bool PERM = true, AFTER_DRAIN = false;
    bf16_t* O; const float* ssq; int ldo;
    __device__ __forceinline__ void operator()(const f32x4 (&acc)[2][2][MT][2], const Unit& u, int wr, int wc, int fr, int fq) const {
        const int row0 = u.pm * (64 * MT) + wr * (16 * MT) + fr, col0 = u.pn * HALF + wc * 32 + 8 * fq;
        float sv[2][MT];
#pragma unroll
        for (int ai = 0; ai < 2; ++ai)
#pragma unroll
            for (int m = 0; m < MT; ++m) sv[ai][m] = ssq[row0 + ai * (32 * MT) + m * 16];
#pragma unroll
        for (int ai = 0; ai < 2; ++ai)
#pragma unroll
            for (int m = 0; m < MT; ++m) {
                const int row = row0 + ai * (32 * MT) + m * 16;
                const float rs = rsqrtf(sv[ai][m] * (1.0f / 2048.0f) + RMS_EPS);
                const f32x4 g0 = acc[ai][0][m][0] * rs, g1 = acc[ai][0][m][1] * rs, u0 = acc[ai][1][m][0] * rs, u1 = acc[ai][1][m][1] * rs;
                const f32x4 o0 = g0 * sigm4(g0) * u0, o1 = g1 * sigm4(g1) * u1;
                u32x4 w; w.x = cvt_pk_bf16(o0[0], o0[1]); w.y = cvt_pk_bf16(o0[2], o0[3]); w.z = cvt_pk_bf16(o1[0], o1[1]); w.w = cvt_pk_bf16(o1[2], o1[3]);
                if (ldo) *(u32x4*)(O + (size_t)row * ldo + col0) = w;
                else { const int pnl = row / ACT_PR, rr = row - pnl * ACT_PR;
                    *(u32x4*)((char*)O + (size_t)pnl * ((FFH / 32) * ACT_PR * 64) + (size_t)(col0 >> 5) * (ACT_PR * 64) + rr * 64 + (col0 & 31) * 2) = w; }
            }
    }
};
template <int MT> struct EpiProj {
    static constexpr bool PERM = true, AFTER_DRAIN = false;
    bf16_t* O; int ldo;
    __device__ __forceinline__ void operator()(const f32x4 (&acc)[2][2][MT][2], const Unit& u, int wr, int wc, int fr, int fq) const {
        const int row0 = u.pm * (64 * MT) + wr * (16 * MT) + fr, col0 = u.pn * BM + wc * 32 + 8 * fq;
#pragma unroll
        for (int ai = 0; ai < 2; ++ai)
#pragma unroll
            for (int m = 0; m < MT; ++m) {
                bf16_t* rowp = O + (size_t)(row0 + ai * (32 * MT) + m * 16) * ldo + col0;
#pragma unroll
                for (int bj = 0; bj < 2; ++bj) { const f32x4 v0 = acc[ai][bj][m][0], v1 = acc[ai][bj][m][1];
                    u32x4 w; w.x = cvt_pk_bf16(v0[0], v0[1]); w.y = cvt_pk_bf16(v0[2], v0[3]); w.z = cvt_pk_bf16(v1[0], v1[1]); w.w = cvt_pk_bf16(v1[2], v1[3]);
                    *(u32x4*)(rowp + bj * HALF) = w; }
            }
    }
};
__device__ __forceinline__ f32x4 bf4_to_f32(u32x2 w) { f32x4 v; v[0] = __uint_as_float(w.x << 16); v[1] = __uint_as_float(w.x & 0xffff0000u); v[2] = __uint_as_float(w.y << 16); v[3] = __uint_as_float(w.y & 0xffff0000u); return v; }
template <int MODE, int MT, bool BASEF32> struct EpiRes {
    static constexpr bool PERM = true, AFTER_DRAIN = false;
    const float* baseP; const float* baseS; const bf16_t* baseHb; float* outH; bf16_t* outHb; float* ssq_out; const float* ssq_in; const bf16_t* proj; float scale; int ldhb;
    __device__ __forceinline__ void operator()(const f32x4 (&acc)[2][2][MT][2], const Unit& u, int wr, int wc, int fr, int fq) const {
        asm volatile("" : "+v"(fr), "+v"(fq));
        constexpr int NB = (MODE == 1) ? 1 : 2;
        constexpr int MB = (MT == 4) ? 2 : ((MODE == 2) ? 1 : 3);
        const int row0 = u.pm * (64 * MT) + wr * (16 * MT) + fr;
        const int col0 = (MODE == 1 ? u.pn * HALF : u.pn * BM) + wc * 32 + 8 * fq;
#pragma unroll
        for (int ai = 0; ai < 2; ++ai)
#pragma unroll
            for (int mb = 0; mb < MT; mb += MB) {
                f32x4 hb[MB][NB][2]; u32x4 hw[MB][NB]; u32x4 pj[MB][NB]; float sv[MB];
#pragma unroll
                for (int mm = 0; mm < MB; ++mm) {
                    const int row = row0 + ai * (32 * MT) + (mb + mm) * 16;
                    if (MODE == 2) sv[mm] = ssq_in[row];
#pragma unroll
                    for (int bj = 0; bj < NB; ++bj) { const int cc = col0 + bj * HALF;
                        if (BASEF32) { const float* xp = (row < MPROMPT ? baseP : baseS - (size_t)MPROMPT * DM) + (size_t)row * DM + cc; hb[mm][bj][0] = *(const f32x4*)xp; hb[mm][bj][1] = *(const f32x4*)(xp + 4); }
                        else hw[mm][bj] = *(const u32x4*)(baseHb + (size_t)row * ldhb + cc);
                        if (MODE == 2) pj[mm][bj] = *(const u32x4*)(proj + (size_t)row * DM + cc); }
                }
#pragma unroll
                for (int mm = 0; mm < MB; ++mm) {
                    const int m = mb + mm, row = row0 + ai * (32 * MT) + m * 16;
                    float rs = 1.f; if (MODE == 2) rs = rsqrtf(sv[mm] * (1.0f / 2048.0f) + RMS_EPS);
                    float s = 0.f;
#pragma unroll
                    for (int bj = 0; bj < NB; ++bj) {
                        const int cc = col0 + bj * HALF;
                        f32x4 hn[2];
#pragma unroll
                        for (int n = 0; n < 2; ++n) {
                            f32x4 val;
                            if (MODE == 0) val = acc[ai][bj][m][n] * scale;
                            else if (MODE == 1) val = acc[ai][0][m][n] * sigm4(acc[ai][1][m][n]);
                            else { u32x2 pw; pw.x = n ? pj[mm][bj].z : pj[mm][bj].x; pw.y = n ? pj[mm][bj].w : pj[mm][bj].y; val = bf4_to_f32(pw) * sigm4(acc[ai][bj][m][n] * rs); }
                            f32x4 bs;
                            if (BASEF32) bs = hb[mm][bj][n];
                            else { u32x2 bw; bw.x = n ? hw[mm][bj].z : hw[mm][bj].x; bw.y = n ? hw[mm][bj].w : hw[mm][bj].y; bs = bf4_to_f32(bw); }
                            hn[n] = bs + val;
                            s += (hn[n][0] * hn[n][0] + hn[n][1] * hn[n][1]) + (hn[n][2] * hn[n][2] + hn[n][3] * hn[n][3]);
                        }
                        if (outH) { float* op = outH + (size_t)row * DM + cc; *(f32x4*)op = hn[0]; *(f32x4*)(op + 4) = hn[1]; }
                        if (outHb) { u32x4 w; w.x = cvt_pk_bf16(hn[0][0], hn[0][1]); w.y = cvt_pk_bf16(hn[0][2], hn[0][3]); w.z = cvt_pk_bf16(hn[1][0], hn[1][1]); w.w = cvt_pk_bf16(hn[1][2], hn[1][3]);
                            *(u32x4*)(outHb + (size_t)row * ldhb + cc) = w; }
                    }
                    if (ssq_out) { s += __shfl_xor(s, 16); s += __shfl_xor(s, 32); if (fq == 0) unsafeAtomicAdd(ssq_out + row, s); }
                }
                asm volatile("" ::: "memory");
            }
    }
};
template <int KIND, int MT> struct EpiHead {
    static constexpr bool PERM = true, AFTER_DRAIN = false;
    const float* ssq_in; const float* gain; float qscale; PG8_LAS float* xch;
    bf16_t* kP; bf16_t* kS; bf16_t* vP; bf16_t* vS; float* o_pk; float* o_pv; float* o_sk; float* o_sv; int ldq;
    __device__ __forceinline__ void operator()(const f32x4 (&acc)[2][2][MT][2], const Unit& u, int wr, int wc, int fr, int fq) const {
        asm volatile("" : "+v"(fr), "+v"(fq));
        const bool isV = (KIND == 0) && (u.pn >= 8);
        const int rl0 = wr * (16 * MT) + fr;
#pragma unroll
        for (int ai = 0; ai < 2; ++ai)
#pragma unroll
            for (int m = 0; m < MT; ++m) {
                const int rl = rl0 + ai * (32 * MT) + m * 16;

#pragma unroll
                for (int bj = 0; bj < 2; ++bj) {
                    const f32x4 a = acc[ai][bj][m][0], b = acc[ai][bj][m][1];
                    float s = (a[0] * a[0] + a[1] * a[1]) + (a[2] * a[2] + a[3] * a[3]) + (b[0] * b[0] + b[1] * b[1]) + (b[2] * b[2] + b[3] * b[3]);
                    s += __shfl_xor(s, 16); s += __shfl_xor(s, 32);
                    if (fq == 0) xch[(bj * 256 + rl) * 4 + wc] = s;
                }
            }
        asm volatile("s_waitcnt lgkmcnt(0)" ::: "memory"); __builtin_amdgcn_s_barrier(); asm volatile("" ::: "memory");
        const int cw = wc * 32 + 8 * fq;
        const int ct = (u.pn & 7) * BM + cw;
        float sv[2][MT];
#pragma unroll
        for (int ai = 0; ai < 2; ++ai)
#pragma unroll
            for (int m = 0; m < MT; ++m) sv[ai][m] = ssq_in[u.pm * (64 * MT) + rl0 + ai * (32 * MT) + m * 16];
#pragma unroll
        for (int ai = 0; ai < 2; ++ai)
#pragma unroll
            for (int m = 0; m < MT; ++m) {
                const int rl = rl0 + ai * (32 * MT) + m * 16, row = u.pm * (64 * MT) + rl;
                const float rs = rsqrtf(sv[ai][m] * (1.0f / 2048.0f) + RMS_EPS);
                bf16_t* dst; float* fdst = nullptr;
                if (KIND == 1) dst = kP + (size_t)row * ldq;
                else if (row < MPROMPT) { dst = (isV ? vP : kP) + (size_t)row * DM; const int t = row & 4095; if (t >= 3584) fdst = (isV ? o_pv : o_pk) + (size_t)((row >> 12) * 512 + t - 3584) * DM; }
                else { const int r2 = row - MPROMPT; dst = (isV ? vS : kS) + (size_t)((r2 >> 6) * 576 + 512 + (r2 & 63)) * DM; fdst = (isV ? o_sv : o_sk) + (size_t)r2 * DM; }
#pragma unroll
                for (int bj = 0; bj < 2; ++bj) {
                    const f32x4 ps = *(const PG8_LAS f32x4*)(xch + (bj * 256 + rl) * 4);
                    float sc = rs;
                    if (!isV) { const float ss = ((ps[0] + ps[1]) + (ps[2] + ps[3])) * rs * rs; sc = rs * rsqrtf(ss * (1.0f / 128.0f) + RMS_EPS) * qscale; }
                    f32x4 v0 = acc[ai][bj][m][0] * sc, v1 = acc[ai][bj][m][1] * sc;
                    if (!isV) { v0 = v0 * *(const f32x4*)(gain + cw); v1 = v1 * *(const f32x4*)(gain + cw + 4); }
                    u32x4 w; w.x = cvt_pk_bf16(v0[0], v0[1]); w.y = cvt_pk_bf16(v0[2], v0[3]); w.z = cvt_pk_bf16(v1[0], v1[1]); w.w = cvt_pk_bf16(v1[2], v1[3]);
                    *(u32x4*)(dst + ct + bj * HALF) = w;
                    if (KIND == 0 && fdst) { *(f32x4*)(fdst + ct + bj * HALF) = v0; *(f32x4*)(fdst + ct + bj * HALF + 4) = v1; }
                }
            }
    }
};
template <class Epi, class Sched, bool ALIGN_EPI = false, bool SP2 = false, int MT = 4>
__device__ __forceinline__ void gemm_phase(PG8_LAS unsigned char* lds, const Gemm g, const Sched& S, const Epi& E) {
    int tid = threadIdx.x; asm volatile("" : "+v"(tid));
    const int wid = __builtin_amdgcn_readfirstlane(tid >> 6), lane = tid & 63, wr = wid >> 2, wc = wid & 3, fr = lane & 15, fq = lane >> 4;
    const int K = g.K, nt = K / BK, lda = g.lda, ldb = g.ldb; constexpr int HA = 32 * MT;
    unsigned voffA[2], voffB[2];
#pragma unroll
    for (int i = 0; i < 2; ++i) { int R, C; stage_rc(tid * 16 + i * 8192, R, C); const int Rb = Epi::PERM ? ((R & ~31) + perm32(R & 31)) : R;
        const int Ra = (R >= HA) ? R - 32 : R; voffA[i] = g.sbA ? (unsigned)((C >> 5) * g.sbA + Ra * 32 + (C & 31)) * 2u : (unsigned)(Ra * lda + C) * 2u; voffB[i] = (unsigned)(Rb * ldb + C) * 2u; }
    const size_t kstepA = g.ksA ? (size_t)g.ksA : (size_t)(BK * 2), kstepB = g.ksB ? (size_t)g.ksB : (size_t)(BK * 2);
    const size_t hstepA = g.sbA ? (size_t)HA * 64 : (size_t)HA * lda * 2, hstepB = (size_t)HALF * ldb * 2;
    const size_t tstepA = g.tsA ? (size_t)g.tsA : 2 * hstepA, tstepB = g.tsB ? (size_t)g.tsB : 2 * hstepB;
    const unsigned ldsw = (unsigned)wid * 1024u;
    const int aoff = lds_byte(wr * (16 * MT) + fr, fq * 8), boff = lds_byte(wc * 32 + fr, fq * 8);
#define PG8_SA(b, h) (((b) * 2 + (h)) * HTB)
#define PG8_SB(b, h) ((4 + (b) * 2 + (h)) * HTB)
#define PG8_STAGE(bufoff, gbase, voff) do { _Pragma("unroll") for (int _i = 0; _i < 2; ++_i) \
        __builtin_amdgcn_global_load_lds((const unsigned*)((const char*)(gbase) + (voff)[_i]), (PG8_LAS unsigned*)(lds + (bufoff) + ldsw + _i * 8192), 16, 0, 0); } while (0)
#define PG8_LDA(dst, b, h) do { _Pragma("unroll") for (int m = 0; m < MT; ++m) _Pragma("unroll") for (int k = 0; k < 2; ++k) dst[m][k] = *(const PG8_LAS bf16x8*)(lds + PG8_SA(b, h) + aoff + m * 2048 + k * 1024); } while (0)
#define PG8_LDB(dst, b, h) do { _Pragma("unroll") for (int n = 0; n < 2; ++n) _Pragma("unroll") for (int k = 0; k < 2; ++k) dst[n][k] = *(const PG8_LAS bf16x8*)(lds + PG8_SB(b, h) + boff + n * 2048 + k * 1024); } while (0)
#define PG8_MMA(ai, bj, At, Bt) do { __builtin_amdgcn_s_setprio(1); _Pragma("unroll") for (int m = 0; m < MT; ++m) _Pragma("unroll") for (int n = 0; n < 2; ++n) _Pragma("unroll") for (int k = 0; k < 2; ++k) \
        acc[ai][bj][m][n] = __builtin_amdgcn_mfma_f32_16x16x32_bf16(Bt[n][k], At[m][k], acc[ai][bj][m][n], 0, 0, 0); __builtin_amdgcn_s_setprio(0); } while (0)
#define PG8_WAIT_V(n) asm volatile("s_waitcnt vmcnt(" #n ")" ::: "memory")
#define PG8_WAIT_L(n) asm volatile("s_waitcnt lgkmcnt(" #n ")" ::: "memory")
#define PG8_BAR __builtin_amdgcn_s_barrier()
#define PG8_SCHED __builtin_amdgcn_sched_barrier(0)
    Unit cur, nxt; int ui = 0;
    if (!S.next(0, cur)) return;
    f32x4 acc[2][2][MT][2];
#pragma unroll
    for (int a = 0; a < 2; ++a)
#pragma unroll
        for (int b = 0; b < 2; ++b)
#pragma unroll
            for (int m = 0; m < MT; ++m)
#pragma unroll
                for (int n = 0; n < 2; ++n) acc[a][b][m][n] = (f32x4){0.f, 0.f, 0.f, 0.f};
    bf16x8 At[MT][2], B0[2][2], B1[2][2];
    const char* cA = (const char*)g.A + (size_t)cur.pm * tstepA; const char* cB = (const char*)g.Bt + (size_t)cur.pn * tstepB;
    S.a_ready(cur);
    if constexpr (SP2) {
        PG8_STAGE(PG8_SB(0, 0), cB, voffB); PG8_STAGE(PG8_SB(0, 1), cB + hstepB, voffB); PG8_STAGE(PG8_SA(0, 0), cA, voffA); PG8_STAGE(PG8_SA(0, 1), cA + hstepA, voffA);
        if (wr == 1) PG8_BAR;
        PG8_WAIT_V(2); PG8_BAR;
        PG8_STAGE(PG8_SB(1, 0), cB + kstepB, voffB); PG8_STAGE(PG8_SA(1, 0), cA + kstepA, voffA); PG8_STAGE(PG8_SB(1, 1), cB + hstepB + kstepB, voffB);
        PG8_WAIT_V(6); PG8_BAR;
    } else {
        PG8_STAGE(PG8_SB(0, 0), cB, voffB); PG8_STAGE(PG8_SA(0, 0), cA, voffA); PG8_STAGE(PG8_SB(0, 1), cB + hstepB, voffB); PG8_STAGE(PG8_SA(0, 1), cA + hstepA, voffA);
        if (wr == 1) PG8_BAR;
        PG8_WAIT_V(4); PG8_BAR;
        PG8_STAGE(PG8_SB(1, 0), cB + kstepB, voffB); PG8_STAGE(PG8_SA(1, 0), cA + kstepA, voffA); PG8_STAGE(PG8_SB(1, 1), cB + hstepB + kstepB, voffB);
        PG8_WAIT_V(6); PG8_BAR;
    }
    for (;;) {
        const bool has_next = S.next(ui + 1, nxt);
        const char* nA = has_next ? (const char*)g.A + (size_t)nxt.pm * tstepA : cA; const char* nB = has_next ? (const char*)g.Bt + (size_t)nxt.pn * tstepB : cB;
        for (int t = 0; t < nt; t += 2) {
            const bool last = (t == nt - 2);
            const char* a1 = cA + (size_t)(t + 1) * kstepA;
            const char* a2 = last ? nA : cA + (size_t)(t + 2) * kstepA; const char* b2 = last ? nB : cB + (size_t)(t + 2) * kstepB;
            const char* a3 = a2 + kstepA; const char* b3 = b2 + kstepB;
            if (last && has_next) S.a_ready(nxt);
            if constexpr (SP2) {
            PG8_LDB(B0, 0, 0); PG8_LDB(B1, 0, 1); PG8_SCHED; PG8_LDA(At, 0, 0); PG8_STAGE(PG8_SA(1, 1), a1 + hstepA, voffA);
            PG8_WAIT_V(8); PG8_WAIT_L(0); PG8_BAR; PG8_MMA(0, 0, At, B0); PG8_MMA(0, 1, At, B1); PG8_BAR; PG8_SCHED;
            PG8_LDA(At, 0, 1); PG8_STAGE(PG8_SB(0, 0), b2, voffB); PG8_STAGE(PG8_SB(0, 1), b2 + hstepB, voffB); PG8_STAGE(PG8_SA(0, 0), a2, voffA);
            PG8_WAIT_V(8); PG8_WAIT_L(0); PG8_BAR; PG8_MMA(1, 0, At, B0); PG8_MMA(1, 1, At, B1); PG8_BAR; PG8_SCHED;
            PG8_LDB(B0, 1, 0); PG8_LDB(B1, 1, 1); PG8_SCHED; PG8_LDA(At, 1, 0); PG8_STAGE(PG8_SA(0, 1), a2 + hstepA, voffA);
            PG8_WAIT_V(8); PG8_WAIT_L(0); PG8_BAR; PG8_MMA(0, 0, At, B0); PG8_MMA(0, 1, At, B1); PG8_BAR; PG8_SCHED;
            PG8_LDA(At, 1, 1); PG8_STAGE(PG8_SB(1, 0), b3, voffB); PG8_STAGE(PG8_SB(1, 1), b3 + hstepB, voffB); PG8_STAGE(PG8_SA(1, 0), a3, voffA);
            PG8_WAIT_V(8); PG8_WAIT_L(0); PG8_BAR; PG8_MMA(1, 0, At, B0); PG8_MMA(1, 1, At, B1); PG8_BAR; PG8_SCHED;
            } else {
            PG8_LDB(B0, 0, 0); PG8_SCHED; PG8_LDA(At, 0, 0); PG8_STAGE(PG8_SA(1, 1), a1 + hstepA, voffA);
            PG8_WAIT_L(8); PG8_BAR; PG8_WAIT_L(0); PG8_MMA(0, 0, At, B0); PG8_BAR; PG8_SCHED;
            PG8_LDB(B1, 0, 1); PG8_STAGE(PG8_SB(0, 0), b2, voffB);
            PG8_BAR; PG8_WAIT_L(0); PG8_MMA(0, 1, At, B1); PG8_BAR;
            PG8_LDA(At, 0, 1); PG8_STAGE(PG8_SA(0, 0), a2, voffA);
            PG8_BAR; PG8_WAIT_L(0); PG8_MMA(1, 0, At, B0); PG8_BAR; PG8_SCHED;
            PG8_STAGE(PG8_SB(0, 1), b2 + hstepB, voffB);
            PG8_WAIT_V(6); PG8_BAR; PG8_MMA(1, 1, At, B1); PG8_BAR;
            PG8_LDB(B0, 1, 0); PG8_SCHED; PG8_LDA(At, 1, 0); PG8_STAGE(PG8_SA(0, 1), a2 + hstepA, voffA);
            PG8_WAIT_L(8); PG8_BAR; PG8_WAIT_L(0); PG8_MMA(0, 0, At, B0); PG8_BAR; PG8_SCHED;
            PG8_LDB(B1, 1, 1); PG8_STAGE(PG8_SB(1, 0), b3, voffB);
            PG8_BAR; PG8_WAIT_L(0); PG8_MMA(0, 1, At, B1); PG8_BAR;
            PG8_LDA(At, 1, 1); PG8_STAGE(PG8_SA(1, 0), a3, voffA);
            PG8_BAR; PG8_WAIT_L(0); PG8_MMA(1, 0, At, B0); PG8_BAR; PG8_SCHED;
            PG8_STAGE(PG8_SB(1, 1), b3 + hstepB, voffB);
            PG8_WAIT_V(6); PG8_BAR; PG8_MMA(1, 1, At, B1); PG8_BAR;
            }
        }
        if constexpr (ALIGN_EPI) { if (wr == 0) PG8_BAR; }
        if constexpr (!Epi::AFTER_DRAIN) { E(acc, cur, wr, wc, fr, fq); S.done(cur); }
        if (!has_next) break;
#pragma unroll
        for (int a = 0; a < 2; ++a)
#pragma unroll
            for (int b = 0; b < 2; ++b)
#pragma unroll
                for (int m = 0; m < MT; ++m)
#pragma unroll
                    for (int n = 0; n < 2; ++n) acc[a][b][m][n] = (f32x4){0.f, 0.f, 0.f, 0.f};
        cur = nxt; cA = nA; cB = nB; ++ui;
        if constexpr (ALIGN_EPI) { if (wr == 1) PG8_BAR; }
    }
    PG8_WAIT_V(0);
    if constexpr (!ALIGN_EPI) { if (wr == 0) PG8_BAR; }
    PG8_BAR;
    if constexpr (Epi::AFTER_DRAIN) { E.fused(acc, cur, wr, wc, fr, fq, lds, wid, lane); S.done(cur); }
#undef PG8_SA
#undef PG8_SB
#undef PG8_STAGE
#undef PG8_LDA
#undef PG8_LDB
#undef PG8_MMA
#undef PG8_WAIT_V
#undef PG8_WAIT_L
#undef PG8_BAR
#undef PG8_SCHED
}
}

constexpr int NWAVES = 8;
constexpr int M = 18432, MP = 16384, MS = 2048, D = 2048, FF = 5632, NH = 16, HD = 128, PLE = 256;
constexpr int SEQ = 4096, DSEQ = 64, DB = 32, NG = 128, NP = 64, CROWS = 512, SROWS = 576;
#ifndef MK_ONE_LAUNCH
#define MK_ONE_LAUNCH 1
#endif
constexpr int N_PHASES = 24;
#ifndef WD_BLOCKED
#define WD_BLOCKED 0
#endif
#ifndef ACT_BLOCKED
#define ACT_BLOCKED 1
#endif
#ifndef MT_DOWN
#define MT_DOWN 3
#endif
#ifndef WGM_UP
#define WGM_UP 8
#endif
#ifndef SP2_UP
#define SP2_UP true
#endif
#ifndef WGM_N2048
#define WGM_N2048 4
#endif
#ifndef ALIGN_RES
#define ALIGN_RES false
#endif
#ifndef MT_UP
#define MT_UP 4
#endif
#ifndef MT_N2048
#define MT_N2048 3
#endif
#ifndef WGM_N4096
#define WGM_N4096 4
#endif
#ifndef MT_N4096
#define MT_N4096 4
#endif
constexpr size_t MiB = 1u << 20;
#ifndef KPAD
#define KPAD 64
#endif
constexpr int LDH = D + KPAD, LDACT = FF + KPAD, LDPB = PLE + KPAD;
constexpr size_t WS_CTL = 0, CTL_ZERO_BYTES = 1 * MiB;
constexpr size_t WS_SSQ = 256 * 1024;
constexpr size_t WS_WL = 2 * MiB, WL_STRIDE = 149 * MiB;
constexpr size_t WL_1GU = 0, WL_1D = 46 * MiB, WL_2GU = 69 * MiB, WL_2D = 115 * MiB, WL_PG = 138 * MiB, WL_PP = 147 * MiB;
constexpr size_t WS_WGLU = 300 * MiB, WS_WKV = 317 * MiB, WS_WQ = 334 * MiB, WS_WO = 343 * MiB;
constexpr size_t WS_HB = 352 * MiB;
constexpr size_t WS_ACT = 427 * MiB;
constexpr size_t WS_PROJ = 628 * MiB;
constexpr size_t WS_KP = 700 * MiB, WS_VP = 764 * MiB;
constexpr size_t WS_KS = 828 * MiB, WS_VS = 900 * MiB;
constexpr size_t WS_PB = 972 * MiB;
constexpr size_t WS_S5L = 1011 * MiB;
constexpr size_t WS_S5B = 1012 * MiB;
constexpr size_t WS_TAB = 1013 * MiB;
constexpr size_t WS_HB2 = 1014 * MiB;
constexpr size_t WS_END = 1089 * MiB;
static_assert((size_t)M * LDH * 2 <= 75 * MiB && (size_t)M * LDACT * 2 <= 201 * MiB && (size_t)2 * FF * LDH * 2 <= 46 * MiB && (size_t)D * LDACT * 2 <= 23 * MiB && (size_t)D * LDH * 2 <= 9 * MiB && (size_t)D * LDPB * 2 <= 2 * MiB && (size_t)2 * M * LDPB * 2 <= 23 * MiB && (size_t)2 * D * LDH * 2 <= 17 * MiB, "d_ws map");
constexpr int CW_BAR = 4096;
constexpr int RING_BYTES = 131072, XCH_OFF = 131072, XCH_BYTES = 8192, MISC_OFF = XCH_OFF + XCH_BYTES, LDS_BYTES = 147456;

#define GAS __attribute__((address_space(1)))
#define LAS __attribute__((address_space(3)))
typedef unsigned short bf16;
typedef unsigned v4u __attribute__((ext_vector_type(4)));
typedef unsigned v2u __attribute__((ext_vector_type(2)));
typedef float f32x4 __attribute__((ext_vector_type(4)));
typedef float f32x16 __attribute__((ext_vector_type(16)));
typedef short bf16x8 __attribute__((ext_vector_type(8)));
typedef short s16x4 __attribute__((ext_vector_type(4)));
typedef GAS unsigned gu32;
#define RLX_AGENT __ATOMIC_RELAXED, __HIP_MEMORY_SCOPE_AGENT
#define LDS_WAIT() asm volatile("s_waitcnt lgkmcnt(0)" ::: "memory")
#define VM_WAIT() asm volatile("s_waitcnt vmcnt(0)" ::: "memory")
__device__ __forceinline__ unsigned pk2(float lo, float hi) { return pg8::cvt_pk_bf16(lo, hi); }
__device__ __forceinline__ float bf2f(unsigned short b) { return __uint_as_float(((unsigned)b) << 16); }
#define XB_TMO      128
#define XB_XCNT(j)  (256  + 64 * (j))
#define XB_XSUB(j)  (1280 + 64 * (j))
#define XB_XGEN(j)  (2304 + 64 * (j))
#define XB_TOP      3328
#define XB_TOPGEN   3392
#define XCD_BAR_WORDS 3456
#define XB_SPIN_CAP (1u << 18)

__device__ __forceinline__ unsigned xb_ld(unsigned* p)              { return __hip_atomic_load(p, __ATOMIC_RELAXED, __HIP_MEMORY_SCOPE_AGENT); }
__device__ __forceinline__ unsigned xb_add(unsigned* p, unsigned v) { return __hip_atomic_fetch_add(p, v, __ATOMIC_RELAXED, __HIP_MEMORY_SCOPE_AGENT); }
__device__ __forceinline__ unsigned xb_xcc_id() { return (unsigned)__builtin_amdgcn_s_getreg((3 << 11) | 20) & 0xFu; }
#define XB_SPIN(cond, bar) do { unsigned _sp = 0; while (cond) { __builtin_amdgcn_s_sleep(1); \
    if ((++_sp & 255u) == 0u) { if (xb_ld(&(bar)[XB_TMO])) break; if (_sp > XB_SPIN_CAP) { atomicAdd(&(bar)[XB_TMO], 1u); break; } } } } while (0)

struct XcdBarrier {
    unsigned* bar; unsigned x;
    volatile LAS unsigned* st;
};

__device__ __forceinline__ XcdBarrier xcd_barrier_post(unsigned* bar, volatile LAS unsigned* st) {
    XcdBarrier b; b.bar = bar; b.x = xb_xcc_id(); b.st = st;
    if (threadIdx.x == 0) (void)xb_add(&bar[XB_XCNT(b.x)], 1u);
    return b;
}
__device__ __forceinline__ void xcd_barrier_complete(unsigned* bar, unsigned x, unsigned& nloc, unsigned& nx) {
    const unsigned G = gridDim.x * gridDim.y * gridDim.z;
    unsigned sum, cnt, mine, sp = 0u;
    for (;;) {
        sum = 0u; cnt = 0u; mine = 0u;
#pragma unroll
        for (unsigned j = 0; j < 16; ++j) { const unsigned c = xb_ld(&bar[XB_XCNT(j)]); sum += c; cnt += (c > 0u) ? 1u : 0u; mine = (j == x) ? c : mine; }
        if (sum == G) break;
        __builtin_amdgcn_s_sleep(1);
        if ((++sp & 255u) == 0u) { if (xb_ld(&bar[XB_TMO])) break; if (sp > XB_SPIN_CAP) { atomicAdd(&bar[XB_TMO], 1u); break; } }
    }
    nloc = mine > 0u ? mine : 1u; nx = cnt > 0u ? cnt : 1u;
}

__device__ __forceinline__ void xcd_barrier(const XcdBarrier& b) {
    asm volatile("s_waitcnt vmcnt(0)" ::: "memory");
    __syncthreads();
    if (threadIdx.x == 0) {
        unsigned* bar = b.bar;
        __builtin_amdgcn_s_waitcnt(0);
        unsigned nloc = b.st[0], nx = b.st[1];
        if (nloc == 0u) { xcd_barrier_complete(bar, b.x, nloc, nx); b.st[0] = nloc; b.st[1] = nx; }
        const unsigned old = xb_add(&bar[XB_XSUB(b.x)], 1u);
        const unsigned gen = old / nloc;
        if (old + 1u == (gen + 1u) * nloc) {
            __builtin_amdgcn_fence(__ATOMIC_RELEASE, "agent");
            asm volatile("s_waitcnt vmcnt(0)" ::: "memory");
            const unsigned og = xb_add(&bar[XB_TOP], 1u);
            const unsigned tg = og / nx;
            if (og + 1u == (tg + 1u) * nx) xb_add(&bar[XB_TOPGEN], 1u);
            else XB_SPIN(xb_ld(&bar[XB_TOPGEN]) == tg, bar);
            __builtin_amdgcn_fence(__ATOMIC_ACQUIRE, "agent");
            xb_add(&bar[XB_XGEN(b.x)], 1u);
            asm volatile("s_waitcnt vmcnt(0)" ::: "memory");
        } else {
            XB_SPIN(xb_ld(&bar[XB_XGEN(b.x)]) == gen, bar);
            __builtin_amdgcn_fence(__ATOMIC_ACQUIRE, "agent");
            asm volatile("s_waitcnt vmcnt(0)" ::: "memory");
        }
    }
    __syncthreads();
}

struct Args { const float* in[38]; float* out; unsigned char* ws; int ph_lo, ph_hi; };
enum { I_XP = 0, I_XS, I_SRE, I_SIM, I_CK, I_CV, I_PP, I_PS, I_F1G, I_F1WG, I_F1WU, I_F1WD, I_F2G, I_F2WG, I_F2WU, I_F2WD, I_MIXG, I_LRE, I_LIM, I_LDT, I_BRE, I_BIM, I_CRE, I_CIM, I_SD, I_GLA, I_GLB,
       I_KVG, I_WK, I_WV, I_KNG, I_WQ, I_QNG, I_RB, I_WO, I_PLG, I_PLWG, I_PLWP };
constexpr size_t O_YP = 0, O_YS = 33554432, O_PSRE = 37748736, O_PSIM = O_PSRE + 32768, O_PK = O_PSIM + 32768, O_PV = O_PK + 4194304, O_SSRE = O_PV + 4194304, O_SSIM = O_SSRE + 262144,
                 O_SK = O_SSIM + 262144, O_SV = O_SK + 4194304, O_END = O_SV + 4194304;
static_assert(O_END == 55115776, "output size");

__device__ __forceinline__ float wave_sum(float v) {
#pragma unroll
    for (int o = 1; o < 64; o <<= 1) v += __shfl_xor(v, o);
    return v;
}
struct TrRegs { float v[32]; };
__device__ __forceinline__ void tr_load(TrRegs& r, const float* W, int N, const float* gain, int item, int lane) {
    const int nblk = N / 32, kb = item / nblk, nb = item % nblk, k0 = 64 * kb, n0 = 32 * nb;
    const float* p = W + (size_t)(k0 + (lane >> 5)) * N + n0 + (lane & 31);
#pragma unroll
    for (int i = 0; i < 32; ++i) r.v[i] = p[(size_t)(2 * i) * N];
    if (gain) {
#pragma unroll
        for (int i = 0; i < 32; ++i) r.v[i] *= gain[k0 + 2 * i + (lane >> 5)];
    }
}
__device__ __forceinline__ void tr_store(const TrRegs& r, int K, int N, bf16* WT, int ldk, int blk, int row_off, LAS float* scr, int item, int lane) {
    const int nblk = N / 32, kb = item / nblk, nb = item % nblk, k0 = 64 * kb, n0 = 32 * nb;
#pragma unroll
    for (int i = 0; i < 32; ++i) scr[(2 * i + (lane >> 5)) * 33 + (lane & 31)] = r.v[i];
    LDS_WAIT(); asm volatile("" ::: "memory");
    const int c = lane & 7;
#pragma unroll
    for (int j = 0; j < 4; ++j) { const int n = (lane >> 3) + 8 * j; const LAS float* s = scr + (8 * c) * 33 + n;
        v4u o; o.x = pk2(s[0 * 33], s[1 * 33]); o.y = pk2(s[2 * 33], s[3 * 33]); o.z = pk2(s[4 * 33], s[5 * 33]); o.w = pk2(s[6 * 33], s[7 * 33]);
        const int nn = n0 + n, drow = (nn >> 7) * blk + (nn & 127) + row_off;
        if (ldk) *(GAS v4u*)(WT + (size_t)drow * ldk + k0 + 8 * c) = o;
        else *(GAS v4u*)((char*)WT + (size_t)(drow >> 8) * ((size_t)(K / 64) * 32768) + (size_t)(k0 >> 6) * 32768 + (drow & 255) * 128 + 16 * c) = o; }
    LDS_WAIT(); asm volatile("" ::: "memory");
}
__device__ __forceinline__ void tr_matrix(const float* W, int K, int N, const float* gain, bf16* WT, int blk, int row_off, LAS float* scr, int gw, int NGW, int lane, int& base, bool blocked = false) {
    const int ldk = blocked ? 0 : K + KPAD;
    const int items = (K / 64) * (N / 32);
    int st = (gw - (base % NGW)); if (st < 0) st += NGW;
    base += items;
    if (st >= items) return;
    TrRegs cur, nxt;
    tr_load(cur, W, N, gain, st, lane);
    for (int it = st; it < items; it += NGW) {
        const bool more = it + NGW < items;
        if (more) tr_load(nxt, W, N, gain, it + NGW, lane);
        tr_store(cur, K, N, WT, ldk, blk, row_off, scr, it, lane);
        if (more) {
#pragma unroll
            for (int i = 0; i < 32; ++i) cur.v[i] = nxt.v[i];
        }
    }
}
__device__ __forceinline__ float row2048_to_bf16(const float* src, bf16* dst, int lane) {
    const GAS f32x4* xr = (const GAS f32x4*)src + lane; GAS v2u* o8 = (GAS v2u*)dst + lane; float s = 0.f;
    f32x4 v[8];
#pragma unroll
    for (int j = 0; j < 8; ++j) v[j] = xr[64 * j];
#pragma unroll
    for (int j = 0; j < 8; ++j) { s += (v[j][0] * v[j][0] + v[j][1] * v[j][1]) + (v[j][2] * v[j][2] + v[j][3] * v[j][3]); v2u w; w.x = pk2(v[j][0], v[j][1]); w.y = pk2(v[j][2], v[j][3]); o8[64 * j] = w; }
    return s;
}


__device__ __forceinline__ pg8::RangeOrder proj_tail(int G, int bx, int part) {
    constexpr int NN = D / 256, P = (M / (64 * MT_N2048)) * NN, NWG_UP = (M / (64 * MT_UP)) * (2 * FF / 256);
    pg8::RangeOrder S; S.nN = NN; S.first = 0; S.count = 0;
    const int rem = NWG_UP % G, ns = G - rem, a = 3 * ns, R = P - a, n2 = R - ns;
    if (rem == 0 || R < 0 || n2 < 0 || n2 > ns) { if (part == 0) { const int per = (P + G - 1) / G; S.first = bx * per; S.count = P - S.first < per ? P - S.first : per; if (S.count < 0) S.count = 0; } return S; }
    const int c = bx - rem;
    if (c < 0) return S;
    if (part == 0) { S.first = 3 * c; S.count = 3; }
    else { S.count = c < n2 ? 2 : 1; S.first = a + (c < n2 ? 2 * c : 2 * n2 + (c - n2)); }
    return S;
}

__device__ __forceinline__ float gelu_tanh(float x) {
    const float a = 0.7978845608028654f * (x + 0.044715f * x * x * x);
    return x * __builtin_amdgcn_rcpf(1.0f + __builtin_amdgcn_exp2f(-2.885390081777927f * a));
}
__device__ __forceinline__ void s5_stage_u(const float* h, const float* ssq, const float* gm, int row0, int g, LAS float* ut, int lane) {
    const int row = row0 + lane;
    const float rs = rsqrtf(ssq[row] * (1.0f / 2048.0f) + 1e-6f);
    const f32x4* hp = (const f32x4*)(h + (size_t)row * D + 16 * g); const f32x4* gp = (const f32x4*)(gm + 16 * g);
#pragma unroll
    for (int k = 0; k < 4; ++k) { const f32x4 v = hp[k] * rs * gp[k]; *(LAS f32x4*)(ut + lane * 16 + 4 * k) = v; }
    LDS_WAIT(); asm volatile("" ::: "memory");
}

__device__ __forceinline__ void s5_prefix(const f32x4* lamtab, float2* E, int gw, int NGW, int lane) {
    float2* HIN = E + (size_t)4 * 64 * NG * NP;
    for (int it = gw; it < 4 * NG; it += NGW) {
        const int g = it & 127, b = it >> 7;
        const f32x4 lam = lamtab[g * 64 + lane];
        const size_t base = ((size_t)b * 64 * 128 + g) * 64 + lane;
        float2 e[63];
#pragma unroll
        for (int c = 0; c < 63; ++c) e[c] = E[base + (size_t)c * 128 * 64];
        float hr = 0.f, hi = 0.f;
        HIN[base] = make_float2(0.f, 0.f);
#pragma unroll
        for (int c = 0; c < 63; ++c) { const float t = lam[2] * hr - lam[3] * hi + e[c].x; hi = lam[2] * hi + lam[3] * hr + e[c].y; hr = t; HIN[base + (size_t)(c + 1) * 128 * 64] = make_float2(hr, hi); }
    }
}
constexpr int S5_HS = 16 * 272;
constexpr int S5_WAVE_LDS = 2 * S5_HS + 2048 + 1024;
template <bool WITH_Y>
__device__ __forceinline__ void s5_mfma(const bf16* h, const float* ssq, const float* gm, const f32x4* lamtab, const float* bbar, const float* cre_g, const float* cim_g, const float* dsk, float2* E,
                                        const float* sre, const float* sim, bf16* zb, float* o_pre, float* o_pim, float* o_sre, float* o_sim, LAS char* wl, int gw, int NGW, int lane, bool emode) {
    const int col = lane & 31, hh = lane >> 5;
    const int NIT = (WITH_Y && !emode) ? (2 * 64 * NG + 16 * NG) : (2 * 64 * NG);
    LAS float* ut = (LAS float*)(wl + 2 * S5_HS); LAS unsigned short* zt = (LAS unsigned short*)(wl + 2 * S5_HS + 2048);
    for (int it = gw; it < NIT; it += NGW) {
        const bool samp = it >= 2 * 64 * NG;
        int g, c, b0;
        if (!samp) { g = it & 127; c = (it >> 7) & 63; b0 = 2 * (it >> 13); } else { const int i2 = it - 2 * 64 * NG; g = i2 & 127; c = 0; b0 = 2 * (i2 >> 7); }
        const int rowbase0 = samp ? MP + b0 * DSEQ : b0 * SEQ + c * 64;
        const int seqstride = samp ? DSEQ : SEQ;
        f32x4 lamA = lamtab[g * 64 + col], lamB = lamtab[g * 64 + col + 32];
        bf16x8 bhi[4], blo[4];
#pragma unroll
        for (int cb = 0; cb < 4; ++cb) { const float* bp = bbar + (size_t)(g * 64 + col + 32 * (cb & 1)) * 32 + 16 * (cb >> 1) + 8 * hh;
            const f32x4 x0 = *(const f32x4*)bp, x1 = *(const f32x4*)(bp + 4); float xv[8] = {x0[0], x0[1], x0[2], x0[3], x1[0], x1[1], x1[2], x1[3]}; unsigned hw[4], lw[4];
#pragma unroll
            for (int j = 0; j < 4; ++j) { const unsigned hp = pk2(xv[2 * j], xv[2 * j + 1]); hw[j] = hp; lw[j] = pk2(xv[2 * j] - __uint_as_float(hp << 16), xv[2 * j + 1] - __uint_as_float(hp & 0xffff0000u)); }
            v4u a; a.x = hw[0]; a.y = hw[1]; a.z = hw[2]; a.w = hw[3]; bhi[cb] = __builtin_bit_cast(bf16x8, a); a.x = lw[0]; a.y = lw[1]; a.z = lw[2]; a.w = lw[3]; blo[cb] = __builtin_bit_cast(bf16x8, a); }
        const f32x4 gm0 = *(const f32x4*)(gm + 16 * g + 8 * hh), gm1 = *(const f32x4*)(gm + 16 * g + 8 * hh + 4);
        bf16x8 cf[4]; float dch = 0.f;
        if (WITH_Y) {
            const int cc = lane & 15, kg = lane >> 4;
#pragma unroll
            for (int s = 0; s < 4; ++s) { const int p0 = 8 * s + 2 * kg;
                const float* cr = cre_g + (size_t)(g * 16 + cc) * 64 + p0; const float* ci = cim_g + (size_t)(g * 16 + cc) * 64 + p0;
                v4u a; a.x = pk2(cr[0], -ci[0]); a.y = pk2(cr[32], -ci[32]); a.z = pk2(cr[1], -ci[1]); a.w = pk2(cr[33], -ci[33]); cf[s] = __builtin_bit_cast(bf16x8, a); }
            dch = dsk[16 * g + cc];
        }
        float hAr = 0.f, hAi = 0.f, hBr = 0.f, hBi = 0.f;
        if (WITH_Y && !emode) {
            if (!samp) { { const float2* hin = E + (size_t)4 * 64 * NG * NP + (((size_t)(b0 + hh) * 64 + c) * 128 + g) * 64;
                    const float2 ea = hin[col], ec = hin[col + 32]; hAr = ea.x; hAi = ea.y; hBr = ec.x; hBi = ec.y; } }
            else { const size_t sb = (size_t)((b0 + hh) * NG + g) * 64; hAr = sre[sb + col]; hAi = sim[sb + col]; hBr = sre[sb + col + 32]; hBi = sim[sb + col + 32]; }
        }
        const int aseq = (col >> 2) & 1, atok = (col & 3) + 4 * (col >> 3);
        {
        const int rb0 = rowbase0; const bool doy = WITH_Y && !emode;
        for (int blk = 0; blk < 4; ++blk) {
            const int arow = rb0 + aseq * seqstride + 16 * blk + atok;
            const float rs = rsqrtf(ssq[arow] * (1.0f / 2048.0f) + 1e-6f);
            const v4u hraw = *(const GAS v4u*)(h + (size_t)arow * LDH + 16 * g + 8 * hh);
            f32x4 h0, h1; h0[0] = __uint_as_float(hraw.x << 16); h0[1] = __uint_as_float(hraw.x & 0xffff0000u); h0[2] = __uint_as_float(hraw.y << 16); h0[3] = __uint_as_float(hraw.y & 0xffff0000u);
            h1[0] = __uint_as_float(hraw.z << 16); h1[1] = __uint_as_float(hraw.z & 0xffff0000u); h1[2] = __uint_as_float(hraw.w << 16); h1[3] = __uint_as_float(hraw.w & 0xffff0000u);
            const f32x4 u0 = h0 * rs * gm0, u1 = h1 * rs * gm1;
            bf16x8 ahi, alo;
            { float xv[8] = {u0[0], u0[1], u0[2], u0[3], u1[0], u1[1], u1[2], u1[3]}; unsigned hw[4], lw[4];
#pragma unroll
              for (int j = 0; j < 4; ++j) { const unsigned hp = pk2(xv[2 * j], xv[2 * j + 1]); hw[j] = hp; lw[j] = pk2(xv[2 * j] - __uint_as_float(hp << 16), xv[2 * j + 1] - __uint_as_float(hp & 0xffff0000u)); }
              v4u a; a.x = hw[0]; a.y = hw[1]; a.z = hw[2]; a.w = hw[3]; ahi = __builtin_bit_cast(bf16x8, a); a.x = lw[0]; a.y = lw[1]; a.z = lw[2]; a.w = lw[3]; alo = __builtin_bit_cast(bf16x8, a); }
            if (WITH_Y && doy) { LAS f32x4* up = (LAS f32x4*)(ut + (aseq * 16 + atok) * 16 + 8 * hh); up[0] = u0; up[1] = u1; }
            f32x16 bu[4];
#pragma unroll
            for (int cb = 0; cb < 4; ++cb) {
#pragma unroll
                for (int i = 0; i < 16; ++i) bu[cb][i] = 0.f;
                bu[cb] = __builtin_amdgcn_mfma_f32_32x32x16_bf16(alo, bhi[cb], bu[cb], 0, 0, 0);
                bu[cb] = __builtin_amdgcn_mfma_f32_32x32x16_bf16(ahi, blo[cb], bu[cb], 0, 0, 0);
                bu[cb] = __builtin_amdgcn_mfma_f32_32x32x16_bf16(ahi, bhi[cb], bu[cb], 0, 0, 0);
            }
#pragma unroll
            for (int i = 0; i < 16; ++i) {
                float t = lamA[0] * hAr - lamA[1] * hAi + bu[0][i]; hAi = lamA[0] * hAi + lamA[1] * hAr + bu[2][i]; hAr = t;
                t = lamB[0] * hBr - lamB[1] * hBi + bu[1][i]; hBi = lamB[0] * hBi + lamB[1] * hBr + bu[3][i]; hBr = t;
                if (WITH_Y && doy) { v2u w; w.x = pk2(hAr, hAi); w.y = pk2(hBr, hBi); *(LAS s16x4*)(wl + hh * S5_HS + i * 272 + col * 8) = __builtin_bit_cast(s16x4, w); }
            }
            if (WITH_Y && doy) {
                asm volatile("" ::: "memory");
                const int cc = lane & 15, kg = lane >> 4;
#pragma unroll
                for (int sq = 0; sq < 2; ++sq) {
                    f32x4 y = {0.f, 0.f, 0.f, 0.f};
#pragma unroll
                    for (int s = 0; s < 4; ++s) { const bf16x8 af = *(const LAS bf16x8*)(wl + sq * S5_HS + cc * 272 + 64 * s + 16 * kg);
                        y = __builtin_amdgcn_mfma_f32_16x16x32_bf16(af, cf[s], y, 0, 0, 0); }
#pragma unroll
                    for (int r = 0; r < 4; ++r) { const float uu = ut[(sq * 16 + 4 * kg + r) * 16 + cc]; const float z = gelu_tanh(y[r] + dch * uu);
                        zt[(sq * 16 + 4 * kg + r) * 16 + cc] = (unsigned short)(pk2(z, 0.f) & 0xffffu); }
                }
                asm volatile("" ::: "memory");
                if (lane < 32) { const int sq = lane >> 4, tok = lane & 15;
                    const bf16x8 z0 = *(const LAS bf16x8*)(zt + lane * 16), z1 = *(const LAS bf16x8*)(zt + lane * 16 + 8);
                    GAS bf16x8* zp = (GAS bf16x8*)(zb + (size_t)(rb0 + sq * seqstride + 16 * blk + tok) * LDH + 16 * g); zp[0] = z0; zp[1] = z1; }
            }
            asm volatile("" ::: "memory");
        }
        }
        if (!WITH_Y || emode) { const size_t eb = (((size_t)(b0 + hh) * 64 + c) * 128 + g) * 64; E[eb + col] = make_float2(hAr, hAi); E[eb + col + 32] = make_float2(hBr, hBi); }
        else if (samp || c == 63) { float* ore = samp ? o_sre : o_pre; float* oim = samp ? o_sim : o_pim; const size_t sb = (size_t)((b0 + hh) * NG + g) * 64;
            ore[sb + col] = hAr; oim[sb + col] = hAi; ore[sb + col + 32] = hBr; oim[sb + col + 32] = hBi; }
    }
}

namespace att {
typedef short v4i16_t __attribute__((ext_vector_type(4)));
constexpr int KBUF = 16384;
constexpr int K_OFF = 0, V_OFF = 2 * KBUF, TAB_OFF = 4 * KBUF, Q_OFF = TAB_OFF + 2560, ATT_LDS = Q_OFF + 8 * 8192;
__device__ __forceinline__ unsigned off_b(unsigned row, unsigned ch) { return 256u * row + 16u * (ch ^ (((row & 3) << 2) | ((row >> 2) & 3))); }
__device__ __forceinline__ s16x4 vtr(const LAS char* p) { return __builtin_bit_cast(s16x4, __builtin_amdgcn_ds_read_tr16_b64_v4i16((LAS v4i16_t*)p)); }
__device__ __forceinline__ int crow(int r, int hi) { return (r & 3) + 8 * (r >> 2) + 4 * hi; }
__device__ __forceinline__ void attn_unit(LAS char* lds, const bf16* Q, size_t qrow0, const bf16* Kseq, const bf16* Vseq, int hh, int cq0, int nqc, const float* tabg, bf16* O, int tid) {
    const int lane = tid & 63, w = __builtin_amdgcn_readfirstlane(tid >> 6), r = lane & 31, h = lane >> 5;
    const int wq = w >> 1; const bool active = wq < nqc; const int cq = cq0 + (active ? wq : 0);
    LAS float* tab = (LAS float*)(lds + TAB_OFF);
    for (int i = tid; i < 640; i += 512) tab[i] = tabg[i];
    const size_t qrow = qrow0 + (size_t)(active ? wq : 0) * 64 + (w & 1) * 32 + r;
    LAS char* qpark = lds + Q_OFF + w * 8192 + lane * 16;
#pragma unroll
    for (int s = 0; s < 8; ++s) *(LAS bf16x8*)(qpark + 1024 * s) = *(const bf16x8*)(Q + qrow * LDH + hh * HD + 16 * s + 8 * h);
    const int kc_lo = (cq0 - 8 > 0) ? cq0 - 8 : 0, kc_hi = cq0 + nqc - 1;
    const int srow0 = tid >> 4, sch = tid & 15;
    v4u kreg[2], vreg[2];
#define ATT_GLOAD(kc) do { _Pragma("unroll") for (int i = 0; i < 2; ++i) { const size_t go = ((size_t)(kc) * 64 + srow0 + 32 * i) * D + hh * HD + sch * 8; kreg[i] = *(const GAS v4u*)(Kseq + go); vreg[i] = *(const GAS v4u*)(Vseq + go); } } while (0)
#define ATT_LSTORE(buf) do { _Pragma("unroll") for (int i = 0; i < 2; ++i) { const unsigned o = off_b(srow0 + 32 * i, sch); *(LAS v4u*)(lds + K_OFF + (buf) * KBUF + o) = kreg[i]; *(LAS v4u*)(lds + V_OFF + (buf) * KBUF + o) = vreg[i]; } } while (0)
    ATT_GLOAD(kc_lo); ATT_LSTORE(0);
    __syncthreads();
    f32x16 o[4];
#pragma unroll
    for (int c = 0; c < 4; ++c)
#pragma unroll
        for (int i = 0; i < 16; ++i) o[c][i] = 0.f;
    float mrun = -1e30f, lsum = 0.f;
    const int tq = 32 * (w & 1) + r;
    const int q4 = (lane & 15) >> 2, p4 = lane & 3, blk16 = (lane >> 4) & 1;
    for (int kc = kc_lo; kc <= kc_hi; ++kc) {
        const int cur = (kc - kc_lo) & 1;
        if (kc < kc_hi) ATT_GLOAD(kc + 1);
        if (active && kc >= cq - 8 && kc <= cq) {
            const int jrel = kc - (cq - 8);
            const LAS char* Kb = lds + K_OFF + cur * KBUF; const LAS char* Vb = lds + V_OFF + cur * KBUF;
            f32x16 p0, p1;
#pragma unroll
            for (int i = 0; i < 16; ++i) { p0[i] = 0.f; p1[i] = 0.f; }
#pragma unroll
            for (int s = 0; s < 8; ++s) {
                const bf16x8 k0 = *(const LAS bf16x8*)(Kb + off_b(r, 2 * s + h)), k1 = *(const LAS bf16x8*)(Kb + off_b(32 + r, 2 * s + h));
                const bf16x8 qs = *(const LAS bf16x8*)(qpark + 1024 * s);
                p0 = __builtin_amdgcn_mfma_f32_32x32x16_bf16(k0, qs, p0, 0, 0, 0); p1 = __builtin_amdgcn_mfma_f32_32x32x16_bf16(k1, qs, p1, 0, 0, 0);
                if ((s & 1) == 1) __builtin_amdgcn_sched_barrier(0);
            }
            const LAS float* tb = tab + (64 * jrel + 63 - tq + 4 * h);
            float mx = -1e30f;
#pragma unroll
            for (int i = 0; i < 16; ++i) { const int kr = (i & 3) + 8 * (i >> 2); p0[i] += tb[kr]; p1[i] += tb[kr + 32]; mx = fmaxf(mx, fmaxf(p0[i], p1[i])); }
            __builtin_amdgcn_sched_barrier(0);
            mx = fmaxf(mx, __shfl_xor(mx, 32));
            const float mnew = fmaxf(mrun, mx), alpha = __builtin_amdgcn_exp2f(mrun - mnew); mrun = mnew;
            float ps = 0.f;
#pragma unroll
            for (int i = 0; i < 16; ++i) { p0[i] = __builtin_amdgcn_exp2f(p0[i] - mnew); p1[i] = __builtin_amdgcn_exp2f(p1[i] - mnew); ps += p0[i] + p1[i]; }
            lsum = lsum * alpha + ps;
#pragma unroll
            for (int c = 0; c < 4; ++c)
#pragma unroll
                for (int i = 0; i < 16; ++i) o[c][i] *= alpha;
#pragma unroll
            for (int blk = 0; blk < 2; ++blk)
#pragma unroll
                for (int s2 = 0; s2 < 2; ++s2) {
                    const f32x16& pp = blk ? p1 : p0;
                    v4u pw; pw.x = pk2(pp[8 * s2], pp[8 * s2 + 1]); pw.y = pk2(pp[8 * s2 + 2], pp[8 * s2 + 3]); pw.z = pk2(pp[8 * s2 + 4], pp[8 * s2 + 5]); pw.w = pk2(pp[8 * s2 + 6], pp[8 * s2 + 7]);
                    const bf16x8 pf = __builtin_bit_cast(bf16x8, pw);
                    const int R0 = 32 * blk + 16 * s2 + 4 * h + q4;
#pragma unroll
                    for (int c = 0; c < 4; ++c) {
                        const unsigned ch = 4 * c + 2 * blk16 + (p4 >> 1);
                        const s16x4 lo = vtr(Vb + off_b(R0, ch) + 8 * (p4 & 1)), hi = vtr(Vb + off_b(R0 + 8, ch) + 8 * (p4 & 1));
                        const bf16x8 vf = __builtin_shufflevector(lo, hi, 0, 1, 2, 3, 4, 5, 6, 7);
                        o[c] = __builtin_amdgcn_mfma_f32_32x32x16_bf16(vf, pf, o[c], 0, 0, 0);
                    }
                    __builtin_amdgcn_sched_barrier(0);
                }
        }
        if (kc < kc_hi) ATT_LSTORE(cur ^ 1);
        __syncthreads();
    }
#undef ATT_GLOAD
#undef ATT_LSTORE
    if (active) {
        const float lt = lsum + __shfl_xor(lsum, 32), inv = 1.0f / lt;
        bf16* op = O + qrow * LDH + hh * HD + 4 * h;
#pragma unroll
        for (int c = 0; c < 4; ++c)
#pragma unroll
            for (int g4 = 0; g4 < 4; ++g4) { v2u wv; wv.x = pk2(o[c][4 * g4] * inv, o[c][4 * g4 + 1] * inv); wv.y = pk2(o[c][4 * g4 + 2] * inv, o[c][4 * g4 + 3] * inv); *(GAS v2u*)(op + 32 * c + 8 * g4) = wv; }
    }
}
static_assert(ATT_LDS <= 139264, "attention LDS");
}

__global__ void __launch_bounds__(NWAVES * 64, 2) mega_fwd(Args args) {
    extern __shared__ __attribute__((aligned(16))) unsigned char lds_raw[];
    LAS unsigned char* lds = (LAS unsigned char*)lds_raw;
    volatile LAS unsigned* MISC = (volatile LAS unsigned*)(lds + MISC_OFF);
    const int tid = threadIdx.x, lane = tid & 63, wave = __builtin_amdgcn_readfirstlane(tid >> 6);
    const int G = gridDim.x, bx = blockIdx.x, vcu = (G % 8 == 0) ? (bx % 8) * (G / 8) + bx / 8 : bx;
    const int gw = vcu * NWAVES + wave, NGW = G * NWAVES;
    unsigned char* ws = args.ws;
    gu32* ctl = (gu32*)(ws + WS_CTL);
    float* ssq = (float*)(ws + WS_SSQ);
    bf16* HB = (bf16*)(ws + WS_HB); bf16* HB2 = (bf16*)(ws + WS_HB2); bf16* ACT = (bf16*)(ws + WS_ACT); bf16* ZQO = (bf16*)(ws + WS_ACT); bf16* PROJ = (bf16*)(ws + WS_PROJ);
    bf16* KP = (bf16*)(ws + WS_KP); bf16* VP = (bf16*)(ws + WS_VP); bf16* KS = (bf16*)(ws + WS_KS); bf16* VS = (bf16*)(ws + WS_VS);
    bf16* PB = (bf16*)(ws + WS_PB); float2* EST = (float2*)(ws + WS_KP);   f32x4* S5L = (f32x4*)(ws + WS_S5L); float* S5B = (float*)(ws + WS_S5B); float* TAB = (float*)(ws + WS_TAB);
    float* Hres = args.out;
    for (int u = tid; u < (LDS_BYTES - MISC_OFF) / 4; u += NWAVES * 64) ((LAS unsigned*)(lds + MISC_OFF))[u] = 0u;
    __syncthreads();
#if MK_ONE_LAUNCH
    XcdBarrier bar = xcd_barrier_post((unsigned*)(ctl + CW_BAR), MISC + 8);
#define GRID_BAR() xcd_barrier(bar)
#else
#define GRID_BAR() do {} while (0)
#endif
    const int lo = args.ph_lo, hi = args.ph_hi;
#define IN(k) (lo <= (k) && (k) < hi)
#define SEAM() GRID_BAR()

    if (IN(0)) {
        LAS float* scr = (LAS float*)(lds + wave * 16384);
        int base = 0;
#pragma unroll
        for (int l = 0; l < 2; ++l) {
            unsigned char* wl = ws + WS_WL + l * WL_STRIDE;
            tr_matrix(args.in[I_F1WG] + (size_t)l * D * FF, D, FF, args.in[I_F1G] + l * D, (bf16*)(wl + WL_1GU), 256, 0, scr, gw, NGW, lane, base);
            tr_matrix(args.in[I_F1WU] + (size_t)l * D * FF, D, FF, args.in[I_F1G] + l * D, (bf16*)(wl + WL_1GU), 256, 128, scr, gw, NGW, lane, base);
            tr_matrix(args.in[I_F1WD] + (size_t)l * D * FF, FF, D, nullptr, (bf16*)(wl + WL_1D), 128, 0, scr, gw, NGW, lane, base, WD_BLOCKED);
            tr_matrix(args.in[I_F2WG] + (size_t)l * D * FF, D, FF, args.in[I_F2G] + l * D, (bf16*)(wl + WL_2GU), 256, 0, scr, gw, NGW, lane, base);
            tr_matrix(args.in[I_F2WU] + (size_t)l * D * FF, D, FF, args.in[I_F2G] + l * D, (bf16*)(wl + WL_2GU), 256, 128, scr, gw, NGW, lane, base);
            tr_matrix(args.in[I_F2WD] + (size_t)l * D * FF, FF, D, nullptr, (bf16*)(wl + WL_2D), 128, 0, scr, gw, NGW, lane, base, WD_BLOCKED);
            tr_matrix(args.in[I_PLWG] + (size_t)l * D * D, D, D, args.in[I_PLG] + l * D, (bf16*)(wl + WL_PG), 128, 0, scr, gw, NGW, lane, base);
            tr_matrix(args.in[I_PLWP] + (size_t)l * PLE * D, PLE, D, nullptr, (bf16*)(wl + WL_PP), 128, 0, scr, gw, NGW, lane, base);
        }
        tr_matrix(args.in[I_GLA], D, D, nullptr, (bf16*)(ws + WS_WGLU), 256, 0, scr, gw, NGW, lane, base);
        tr_matrix(args.in[I_GLB], D, D, nullptr, (bf16*)(ws + WS_WGLU), 256, 128, scr, gw, NGW, lane, base);
        tr_matrix(args.in[I_WK], D, D, args.in[I_KVG], (bf16*)(ws + WS_WKV), 128, 0, scr, gw, NGW, lane, base);
        tr_matrix(args.in[I_WV], D, D, args.in[I_KVG], (bf16*)(ws + WS_WKV), 128, 2048, scr, gw, NGW, lane, base);
        tr_matrix(args.in[I_WQ], D, D, args.in[I_MIXG] + D, (bf16*)(ws + WS_WQ), 128, 0, scr, gw, NGW, lane, base);
        tr_matrix(args.in[I_WO], D, D, nullptr, (bf16*)(ws + WS_WO), 128, 0, scr, gw, NGW, lane, base);
        for (int m = gw; m < M; m += NGW) { const float* src = (m < MP) ? args.in[I_XP] + (size_t)m * D : args.in[I_XS] + (size_t)(m - MP) * D;
            const float s = wave_sum(row2048_to_bf16(src, HB + (size_t)m * LDH, lane)); if (lane == 0) ssq[m] = s; }
        for (int m = gw; m < DB * CROWS; m += NGW) { const int b = m >> 9, t = m & 511;
            (void)row2048_to_bf16(args.in[I_CK] + (size_t)m * D, KS + (size_t)(b * SROWS + t) * D, lane);
            (void)row2048_to_bf16(args.in[I_CV] + (size_t)m * D, VS + (size_t)(b * SROWS + t) * D, lane); }
        for (int m = gw; m < 2 * M; m += NGW) { const int l = m / M, r = m % M;
            const float* src = (r < MP) ? args.in[I_PP] + ((size_t)l * MP + r) * PLE : args.in[I_PS] + ((size_t)l * MS + (r - MP)) * PLE;
            const f32x4 v = ((const GAS f32x4*)src)[lane]; v2u w; w.x = pk2(v[0], v[1]); w.y = pk2(v[2], v[3]); ((GAS v2u*)(PB + (size_t)m * LDPB))[lane] = w; }
        { const int i = gw * 64 + lane;
          if (i < NG * NP) { const int g = i >> 6;
            const double lre = args.in[I_LRE][i], lim = args.in[I_LIM][i], dt = exp((double)args.in[I_LDT][g]);
            const double er = exp(lre * dt), sn = sin(lim * dt), cs = cos(lim * dt), lbr = er * cs, lbi = er * sn;
            const double e128 = exp(lre * dt * 64.0), s128 = sin(lim * dt * 64.0), c128 = cos(lim * dt * 64.0);
            f32x4 lv; lv[0] = (float)lbr; lv[1] = (float)lbi; lv[2] = (float)(e128 * c128); lv[3] = (float)(e128 * s128); S5L[i] = lv;
            const double nr = lbr - 1.0, ni = lbi, den = lre * lre + lim * lim, fr = (nr * lre + ni * lim) / den, fi = (ni * lre - nr * lim) / den;
            for (int c = 0; c < 16; ++c) { const double br = args.in[I_BRE][(size_t)i * 16 + c], bi = args.in[I_BIM][(size_t)i * 16 + c];
                S5B[(size_t)i * 32 + c] = (float)(fr * br - fi * bi); S5B[(size_t)i * 32 + 16 + c] = (float)(fr * bi + fi * br); } } }
        for (int i = gw * 64 + lane; i < NH * 640; i += NGW * 64) { const int hh = i / 640, y = i % 640; int dd = 575 - y; dd = dd < -256 ? -256 : (dd > 256 ? 256 : dd);
            TAB[i] = 1.4426950408889634f * args.in[I_RB][hh * 513 + dd + 256]; }
    }
    SEAM();

    { constexpr int l = 0;

        const int pb = 1 + 10 * l;
        unsigned char* wl = ws + WS_WL + l * WL_STRIDE;
        float* sq = ssq + (size_t)(4 * l) * M;
        if (l == 1 && IN(pb + 0)) {
            pg8::Gemm g{HB2, (const bf16*)(ws + WS_WKV), M, 2 * D, D, LDH, LDH}; pg8::StaticOrder S; S.init(M, 2 * D, G, G - 1 - bx, 64 * MT_N4096, WGM_N4096);
            pg8::EpiHead<0, MT_N4096> E{sq, args.in[I_KNG], 1.0f, (PG8_LAS float*)(lds + XCH_OFF), KP, KS, VP, VS, args.out + O_PK, args.out + O_PV, args.out + O_SK, args.out + O_SV, 0};
            pg8::gemm_phase<pg8::EpiHead<0, MT_N4096>, pg8::StaticOrder, true, true, MT_N4096>(lds, g, S, E);
        }
        if (IN(pb + 1)) {
            pg8::Gemm g{l == 0 ? HB : HB2, (const bf16*)(wl + WL_1GU), M, 2 * FF, D, LDH, LDH}; pg8::StaticOrder S; S.init(M, 2 * FF, G, bx, 64 * MT_UP);
            pg8::EpiUp<MT_UP> E{ACT, sq, ACT_BLOCKED ? 0 : LDACT};
            pg8::gemm_phase<pg8::EpiUp<MT_UP>, pg8::StaticOrder, true, SP2_UP, MT_UP>(lds, g, S, E);
        }
        if (IN(pb + 2)) {
            int kple = PLE; asm volatile("" : "+s"(kple));
            pg8::Gemm g{PB + (size_t)l * M * LDPB, (const bf16*)(wl + WL_PP), M, D, kple, LDPB, LDPB}; const pg8::RangeOrder S = proj_tail(G, bx, 0);
            pg8::EpiProj<MT_N2048> E{PROJ, D};
            pg8::gemm_phase<pg8::EpiProj<MT_N2048>, pg8::RangeOrder, true, true, MT_N2048>(lds, g, S, E);
        }
        SEAM();
        if (IN(pb + 3)) {
            pg8::Gemm g{ACT, (const bf16*)(wl + WL_1D), M, D, FF, ACT_BLOCKED ? 64 : LDACT, WD_BLOCKED ? 64 : LDACT, ACT_BLOCKED ? ACT_PR * 128 : 0, WD_BLOCKED ? 32768 : 0, ACT_BLOCKED ? (long)(FF / 64) * ACT_PR * 128 : 0L, WD_BLOCKED ? (long)(FF / 64) * 32768 : 0L, ACT_BLOCKED ? ACT_PR * 32 : 0}; pg8::StaticOrder S; S.init(M, D, G, bx, 64 * MT_DOWN, WGM_N2048);
            pg8::EpiRes<0, MT_DOWN, l == 0> E{args.in[I_XP], args.in[I_XS], HB2, nullptr, HB, sq + M, nullptr, nullptr, 0.5f, LDH};
            pg8::gemm_phase<pg8::EpiRes<0, MT_DOWN, l == 0>, pg8::StaticOrder, ALIGN_RES, true, MT_DOWN>(lds, g, S, E);
        }
        SEAM();
        if (IN(pb + 4)) {
            if (l == 0) s5_mfma<true>(HB, sq + M, args.in[I_MIXG], S5L, S5B, args.in[I_CRE], args.in[I_CIM], args.in[I_SD], EST, args.in[I_SRE], args.in[I_SIM], ZQO,
                                  args.out + O_PSRE, args.out + O_PSIM, args.out + O_SSRE, args.out + O_SSIM, (LAS char*)(lds + wave * S5_WAVE_LDS), gw, NGW, lane, true);
            else { pg8::Gemm g{HB, (const bf16*)(ws + WS_WQ), M, D, D, LDH, LDH}; pg8::StaticOrder S; S.init(M, D, G, bx, 64 * MT_N2048, WGM_N2048);
                pg8::EpiHead<1, MT_N2048> E{sq + M, args.in[I_QNG], 0.08838834764831845f * 1.4426950408889634f, (PG8_LAS float*)(lds + XCH_OFF), ZQO, nullptr, nullptr, nullptr, nullptr, nullptr, nullptr, nullptr, LDH};
                pg8::gemm_phase<pg8::EpiHead<1, MT_N2048>, pg8::StaticOrder, true, true, MT_N2048>(lds, g, S, E); }
        }
        SEAM();
        if (l == 0) { if (IN(21)) s5_prefix(S5L, EST, gw, NGW, lane); SEAM(); }
        if (IN(pb + 5)) {
            if (l == 0) s5_mfma<true>(HB, sq + M, args.in[I_MIXG], S5L, S5B, args.in[I_CRE], args.in[I_CIM], args.in[I_SD], EST, args.in[I_SRE], args.in[I_SIM], ZQO,
                                  args.out + O_PSRE, args.out + O_PSIM, args.out + O_SSRE, args.out + O_SSIM, (LAS char*)(lds + wave * S5_WAVE_LDS), gw, NGW, lane, false);
            else {
                for (int ui = vcu; ui < 1024 + 512; ui += G) {
                    if (ui < 1024) { const int qb = ui & 15, hh = (ui >> 4) & 15, b = ui >> 8;
                        att::attn_unit((LAS char*)lds, ZQO, (size_t)b * SEQ + 256 * qb, KP + (size_t)b * SEQ * D, VP + (size_t)b * SEQ * D, hh, 4 * qb, 4, TAB + hh * 640, HB2, tid); }
                    else { const int u2 = ui - 1024, hh = u2 & 15, b = u2 >> 4;
                        att::attn_unit((LAS char*)lds, ZQO, (size_t)MP + b * DSEQ, KS + (size_t)b * SROWS * D, VS + (size_t)b * SROWS * D, hh, 8, 1, TAB + hh * 640, HB2, tid); }
                }
            }
        }
        SEAM();
        if (IN(pb + 6)) {
            if (l == 0) { pg8::Gemm g{ZQO, (const bf16*)(ws + WS_WGLU), M, 2 * D, D, LDH, LDH}; pg8::StaticOrder S; S.init(M, 2 * D, G, bx, 64 * MT_N4096, WGM_N4096);
                pg8::EpiRes<1, MT_N4096, false> E{nullptr, nullptr, HB, nullptr, HB, sq + 2 * M, nullptr, nullptr, 1.0f, LDH};
                pg8::gemm_phase<pg8::EpiRes<1, MT_N4096, false>, pg8::StaticOrder, ALIGN_RES, true, MT_N4096>(lds, g, S, E); }
            else { pg8::Gemm g{HB2, (const bf16*)(ws + WS_WO), M, D, D, LDH, LDH}; pg8::StaticOrder S; S.init(M, D, G, bx, 64 * MT_N2048, WGM_N2048);
                pg8::EpiRes<0, MT_N2048, false> E{nullptr, nullptr, HB, nullptr, HB, sq + 2 * M, nullptr, nullptr, 1.0f, LDH};
                pg8::gemm_phase<pg8::EpiRes<0, MT_N2048, false>, pg8::StaticOrder, ALIGN_RES, true, MT_N2048>(lds, g, S, E); }
        }
        SEAM();
        if (IN(pb + 7)) {
            pg8::Gemm g{HB, (const bf16*)(wl + WL_2GU), M, 2 * FF, D, LDH, LDH}; pg8::StaticOrder S; S.init(M, 2 * FF, G, bx, 64 * MT_UP);
            pg8::EpiUp<MT_UP> E{ACT, sq + 2 * M, ACT_BLOCKED ? 0 : LDACT};
            pg8::gemm_phase<pg8::EpiUp<MT_UP>, pg8::StaticOrder, true, SP2_UP, MT_UP>(lds, g, S, E);
        }
        if (IN(22 + l)) {
            int kple = PLE; asm volatile("" : "+s"(kple));
            pg8::Gemm g{PB + (size_t)l * M * LDPB, (const bf16*)(wl + WL_PP), M, D, kple, LDPB, LDPB}; const pg8::RangeOrder S = proj_tail(G, bx, 1);
            pg8::EpiProj<MT_N2048> E{PROJ, D};
            pg8::gemm_phase<pg8::EpiProj<MT_N2048>, pg8::RangeOrder, true, true, MT_N2048>(lds, g, S, E);
        }
        SEAM();
        if (IN(pb + 8)) {
            pg8::Gemm g{ACT, (const bf16*)(wl + WL_2D), M, D, FF, ACT_BLOCKED ? 64 : LDACT, WD_BLOCKED ? 64 : LDACT, ACT_BLOCKED ? ACT_PR * 128 : 0, WD_BLOCKED ? 32768 : 0, ACT_BLOCKED ? (long)(FF / 64) * ACT_PR * 128 : 0L, WD_BLOCKED ? (long)(FF / 64) * 32768 : 0L, ACT_BLOCKED ? ACT_PR * 32 : 0}; pg8::StaticOrder S; S.init(M, D, G, bx, 64 * MT_DOWN, WGM_N2048);
            pg8::EpiRes<0, MT_DOWN, false> E{nullptr, nullptr, HB, nullptr, HB, sq + 3 * M, nullptr, nullptr, 0.5f, LDH};
            pg8::gemm_phase<pg8::EpiRes<0, MT_DOWN, false>, pg8::StaticOrder, ALIGN_RES, true, MT_DOWN>(lds, g, S, E);
        }
        SEAM();
        if (IN(pb + 9)) {
            pg8::Gemm g{HB, (const bf16*)(wl + WL_PG), M, D, D, LDH, LDH}; pg8::StaticOrder S; S.init(M, D, G, bx, 64 * MT_N2048, WGM_N2048);
            pg8::EpiRes<2, MT_N2048, false> E{nullptr, nullptr, HB, l == 0 ? nullptr : Hres, l == 0 ? HB2 : nullptr, l == 0 ? sq + 4 * M : nullptr, sq + 3 * M, PROJ, 1.0f, LDH};
            pg8::gemm_phase<pg8::EpiRes<2, MT_N2048, false>, pg8::StaticOrder, ALIGN_RES, true, MT_N2048>(lds, g, S, E);
        }
        if (l == 0) SEAM();
        }
    { constexpr int l = 1;

        const int pb = 1 + 10 * l;
        unsigned char* wl = ws + WS_WL + l * WL_STRIDE;
        float* sq = ssq + (size_t)(4 * l) * M;
        if (l == 1 && IN(pb + 0)) {
            pg8::Gemm g{HB2, (const bf16*)(ws + WS_WKV), M, 2 * D, D, LDH, LDH}; pg8::StaticOrder S; S.init(M, 2 * D, G, G - 1 - bx, 64 * MT_N4096, WGM_N4096);
            pg8::EpiHead<0, MT_N4096> E{sq, args.in[I_KNG], 1.0f, (PG8_LAS float*)(lds + XCH_OFF), KP, KS, VP, VS, args.out + O_PK, args.out + O_PV, args.out + O_SK, args.out + O_SV, 0};
            pg8::gemm_phase<pg8::EpiHead<0, MT_N4096>, pg8::StaticOrder, true, true, MT_N4096>(lds, g, S, E);
        }
        if (IN(pb + 1)) {
            pg8::Gemm g{l == 0 ? HB : HB2, (const bf16*)(wl + WL_1GU), M, 2 * FF, D, LDH, LDH}; pg8::StaticOrder S; S.init(M, 2 * FF, G, bx, 64 * MT_UP);
            pg8::EpiUp<MT_UP> E{ACT, sq, ACT_BLOCKED ? 0 : LDACT};
            pg8::gemm_phase<pg8::EpiUp<MT_UP>, pg8::StaticOrder, true, SP2_UP, MT_UP>(lds, g, S, E);
        }
        if (IN(pb + 2)) {
            int kple = PLE; asm volatile("" : "+s"(kple));
            pg8::Gemm g{PB + (size_t)l * M * LDPB, (const bf16*)(wl + WL_PP), M, D, kple, LDPB, LDPB}; const pg8::RangeOrder S = proj_tail(G, bx, 0);
            pg8::EpiProj<MT_N2048> E{PROJ, D};
            pg8::gemm_phase<pg8::EpiProj<MT_N2048>, pg8::RangeOrder, true, true, MT_N2048>(lds, g, S, E);
        }
        SEAM();
        if (IN(pb + 3)) {
            pg8::Gemm g{ACT, (const bf16*)(wl + WL_1D), M, D, FF, ACT_BLOCKED ? 64 : LDACT, WD_BLOCKED ? 64 : LDACT, ACT_BLOCKED ? ACT_PR * 128 : 0, WD_BLOCKED ? 32768 : 0, ACT_BLOCKED ? (long)(FF / 64) * ACT_PR * 128 : 0L, WD_BLOCKED ? (long)(FF / 64) * 32768 : 0L, ACT_BLOCKED ? ACT_PR * 32 : 0}; pg8::StaticOrder S; S.init(M, D, G, bx, 64 * MT_DOWN, WGM_N2048);
            pg8::EpiRes<0, MT_DOWN, l == 0> E{args.in[I_XP], args.in[I_XS], HB2, nullptr, HB, sq + M, nullptr, nullptr, 0.5f, LDH};
            pg8::gemm_phase<pg8::EpiRes<0, MT_DOWN, l == 0>, pg8::StaticOrder, ALIGN_RES, true, MT_DOWN>(lds, g, S, E);
        }
        SEAM();
        if (IN(pb + 4)) {
            if (l == 0) s5_mfma<true>(HB, sq + M, args.in[I_MIXG], S5L, S5B, args.in[I_CRE], args.in[I_CIM], args.in[I_SD], EST, args.in[I_SRE], args.in[I_SIM], ZQO,
                                  args.out + O_PSRE, args.out + O_PSIM, args.out + O_SSRE, args.out + O_SSIM, (LAS char*)(lds + wave * S5_WAVE_LDS), gw, NGW, lane, true);
            else { pg8::Gemm g{HB, (const bf16*)(ws + WS_WQ), M, D, D, LDH, LDH}; pg8::StaticOrder S; S.init(M, D, G, bx, 64 * MT_N2048, WGM_N2048);
                pg8::EpiHead<1, MT_N2048> E{sq + M, args.in[I_QNG], 0.08838834764831845f * 1.4426950408889634f, (PG8_LAS float*)(lds + XCH_OFF), ZQO, nullptr, nullptr, nullptr, nullptr, nullptr, nullptr, nullptr, LDH};
                pg8::gemm_phase<pg8::EpiHead<1, MT_N2048>, pg8::StaticOrder, true, true, MT_N2048>(lds, g, S, E); }
        }
        SEAM();
        if (l == 0) { if (IN(21)) s5_prefix(S5L, EST, gw, NGW, lane); SEAM(); }
        if (IN(pb + 5)) {
            if (l == 0) s5_mfma<true>(HB, sq + M, args.in[I_MIXG], S5L, S5B, args.in[I_CRE], args.in[I_CIM], args.in[I_SD], EST, args.in[I_SRE], args.in[I_SIM], ZQO,
                                  args.out + O_PSRE, args.out + O_PSIM, args.out + O_SSRE, args.out + O_SSIM, (LAS char*)(lds + wave * S5_WAVE_LDS), gw, NGW, lane, false);
            else {
                for (int ui = vcu; ui < 1024 + 512; ui += G) {
                    if (ui < 1024) { const int qb = ui & 15, hh = (ui >> 4) & 15, b = ui >> 8;
                        att::attn_unit((LAS char*)lds, ZQO, (size_t)b * SEQ + 256 * qb, KP + (size_t)b * SEQ * D, VP + (size_t)b * SEQ * D, hh, 4 * qb, 4, TAB + hh * 640, HB2, tid); }
                    else { const int u2 = ui - 1024, hh = u2 & 15, b = u2 >> 4;
                        att::attn_unit((LAS char*)lds, ZQO, (size_t)MP + b * DSEQ, KS + (size_t)b * SROWS * D, VS + (size_t)b * SROWS * D, hh, 8, 1, TAB + hh * 640, HB2, tid); }
                }
            }
        }
        SEAM();
        if (IN(pb + 6)) {
            if (l == 0) { pg8::Gemm g{ZQO, (const bf16*)(ws + WS_WGLU), M, 2 * D, D, LDH, LDH}; pg8::StaticOrder S; S.init(M, 2 * D, G, bx, 64 * MT_N4096, WGM_N4096);
                pg8::EpiRes<1, MT_N4096, false> E{nullptr, nullptr, HB, nullptr, HB, sq + 2 * M, nullptr, nullptr, 1.0f, LDH};
                pg8::gemm_phase<pg8::EpiRes<1, MT_N4096, false>, pg8::StaticOrder, ALIGN_RES, true, MT_N4096>(lds, g, S, E); }
            else { pg8::Gemm g{HB2, (const bf16*)(ws + WS_WO), M, D, D, LDH, LDH}; pg8::StaticOrder S; S.init(M, D, G, bx, 64 * MT_N2048, WGM_N2048);
                pg8::EpiRes<0, MT_N2048, false> E{nullptr, nullptr, HB, nullptr, HB, sq + 2 * M, nullptr, nullptr, 1.0f, LDH};
                pg8::gemm_phase<pg8::EpiRes<0, MT_N2048, false>, pg8::StaticOrder, ALIGN_RES, true, MT_N2048>(lds, g, S, E); }
        }
        SEAM();
        if (IN(pb + 7)) {
            pg8::Gemm g{HB, (const bf16*)(wl + WL_2GU), M, 2 * FF, D, LDH, LDH}; pg8::StaticOrder S; S.init(M, 2 * FF, G, bx, 64 * MT_UP);
            pg8::EpiUp<MT_UP> E{ACT, sq + 2 * M, ACT_BLOCKED ? 0 : LDACT};
            pg8::gemm_phase<pg8::EpiUp<MT_UP>, pg8::StaticOrder, true, SP2_UP, MT_UP>(lds, g, S, E);
        }
        if (IN(22 + l)) {
            int kple = PLE; asm volatile("" : "+s"(kple));
            pg8::Gemm g{PB + (size_t)l * M * LDPB, (const bf16*)(wl + WL_PP), M, D, kple, LDPB, LDPB}; const pg8::RangeOrder S = proj_tail(G, bx, 1);
            pg8::EpiProj<MT_N2048> E{PROJ, D};
            pg8::gemm_phase<pg8::EpiProj<MT_N2048>, pg8::RangeOrder, true, true, MT_N2048>(lds, g, S, E);
        }
        SEAM();
        if (IN(pb + 8)) {
            pg8::Gemm g{ACT, (const bf16*)(wl + WL_2D), M, D, FF, ACT_BLOCKED ? 64 : LDACT, WD_BLOCKED ? 64 : LDACT, ACT_BLOCKED ? ACT_PR * 128 : 0, WD_BLOCKED ? 32768 : 0, ACT_BLOCKED ? (long)(FF / 64) * ACT_PR * 128 : 0L, WD_BLOCKED ? (long)(FF / 64) * 32768 : 0L, ACT_BLOCKED ? ACT_PR * 32 : 0}; pg8::StaticOrder S; S.init(M, D, G, bx, 64 * MT_DOWN, WGM_N2048);
            pg8::EpiRes<0, MT_DOWN, false> E{nullptr, nullptr, HB, nullptr, HB, sq + 3 * M, nullptr, nullptr, 0.5f, LDH};
            pg8::gemm_phase<pg8::EpiRes<0, MT_DOWN, false>, pg8::StaticOrder, ALIGN_RES, true, MT_DOWN>(lds, g, S, E);
        }
        SEAM();
        if (IN(pb + 9)) {
            pg8::Gemm g{HB, (const bf16*)(wl + WL_PG), M, D, D, LDH, LDH}; pg8::StaticOrder S; S.init(M, D, G, bx, 64 * MT_N2048, WGM_N2048);
            pg8::EpiRes<2, MT_N2048, false> E{nullptr, nullptr, HB, l == 0 ? nullptr : Hres, l == 0 ? HB2 : nullptr, l == 0 ? sq + 4 * M : nullptr, sq + 3 * M, PROJ, 1.0f, LDH};
            pg8::gemm_phase<pg8::EpiRes<2, MT_N2048, false>, pg8::StaticOrder, ALIGN_RES, true, MT_N2048>(lds, g, S, E);
        }
        if (l == 0) SEAM();
        }
#undef IN
#undef SEAM
}

extern "C" void kernel_launch(void* const* d_in, const int* in_sizes, int n_in, void* d_out, int out_size, void* d_ws, size_t ws_size, hipStream_t stream) {
    static int grid = 0;
    if (grid == 0) {
        if (n_in != 38 || out_size != (int)O_END || ws_size < WS_END) { fprintf(stderr, "kernel_launch: unexpected shapes (n_in %d, out %d, ws %zu)\n", n_in, out_size, ws_size); grid = -1; return; }
        int dev = 0, cus = 0, per_cu = 0;
        if (hipGetDevice(&dev) != hipSuccess || hipDeviceGetAttribute(&cus, hipDeviceAttributeMultiprocessorCount, dev) != hipSuccess) { grid = -1; return; }
        if (hipFuncSetAttribute((const void*)mega_fwd, hipFuncAttributeMaxDynamicSharedMemorySize, LDS_BYTES) != hipSuccess) { fprintf(stderr, "kernel_launch: hipFuncSetAttribute failed\n"); grid = -1; return; }
        if (hipOccupancyMaxActiveBlocksPerMultiprocessor(&per_cu, (const void*)mega_fwd, NWAVES * 64, LDS_BYTES) != hipSuccess || per_cu < 1) { fprintf(stderr, "kernel_launch: occupancy query says %d\n", per_cu); }
        (void)hipGetLastError();
        grid = cus;
    }
    if (grid < 0) return;
    if (hipMemsetAsync((char*)d_ws + WS_CTL, 0, CTL_ZERO_BYTES, stream) != hipSuccess) return;
    Args a{};
    for (int i = 0; i < 38; ++i) a.in[i] = (const float*)d_in[i];
    a.out = (float*)d_out; a.ws = (unsigned char*)d_ws;
#if MK_ONE_LAUNCH
    a.ph_lo = 0; a.ph_hi = N_PHASES;
    hipLaunchKernelGGL(mega_fwd, dim3(grid), dim3(NWAVES * 64), LDS_BYTES, stream, a);
#else
    static const int order[23] = {0, 2, 3, 4, 5, 21, 6, 7, 8, 22, 9, 10, 11, 12, 13, 14, 15, 16, 17, 18, 23, 19, 20};
    for (int oi = 0; oi < 23; ++oi) { const int p = order[oi]; a.ph_lo = p; a.ph_hi = p + 1; int reps = 1;
        for (int r = 0; r < reps; ++r) hipLaunchKernelGGL(mega_fwd, dim3(grid), dim3(NWAVES * 64), LDS_BYTES, stream, a); }
#endif
}
```
